# Optimizing an MI355X kernel written in HIP

```python
import jax, jax.numpy as jnp
from jax import lax
import numpy as np

D_MODEL = 1024
BATCH = 2
SEQ = 16384
DEPTH = 2

N_A = DEPTH // 2
N_B = DEPTH - N_A
PLE_DIM = 256
EPS = 1e-6
NEG = -1e30
BIG = 1e30

RET_HEADS = D_MODEL // 256
RET_QK_DIM = D_MODEL // RET_HEADS
RET_V_DIM = 2 * RET_QK_DIM
RET_QK_W = RET_HEADS * RET_QK_DIM
RET_V_W = RET_HEADS * RET_V_DIM
RET_CHUNK = 128
ROPE_BASE = 10000.0

NSA_DK = 128
NSA_DV = 128
NSA_W = 2 * D_MODEL
NSA_HEADS = NSA_W // NSA_DV
NSA_GROUPS = 4
NSA_HPG = NSA_HEADS // NSA_GROUPS
NSA_KV_W = NSA_GROUPS * NSA_DK
CMP_LEN = 32
CMP_STRIDE = 16
CMP_HIDDEN = 256
SEL_BLOCK = 64
N_SEL = 16
WIN = 512
Q_BLOCK = 128

kernel_name = "yoco_retnet_nsa_hybrid"


def rmsnorm(x, g):
    xf = x.astype(jnp.float32)
    y = xf * lax.rsqrt(jnp.mean(xf * xf, axis=-1, keepdims=True) + EPS)
    return (y * g.astype(jnp.float32)).astype(x.dtype)


def rotary(x, pos):
    half = x.shape[-1] // 2
    inv = ROPE_BASE ** (-jnp.arange(half, dtype=jnp.float32) / half)
    ang = pos.astype(jnp.float32)[:, None] * inv[None, :]
    cos, sin = jnp.cos(ang), jnp.sin(ang)
    x1, x2 = x[..., :half], x[..., half:]
    return jnp.concatenate([x1 * cos - x2 * sin, x1 * sin + x2 * cos], axis=-1)


def retention_chunkwise(q, k, v):
    b, h, t, _ = q.shape
    nc = t // RET_CHUNK
    lg = jnp.log1p(-(2.0 ** (-5.0 - jnp.arange(h, dtype=jnp.float32))))
    pos = jnp.arange(RET_CHUNK, dtype=jnp.float32)
    diff = pos[:, None] - pos[None, :]
    decay = jnp.where(diff[None] >= 0,
                      jnp.exp(jnp.maximum(diff, 0.0)[None] * lg[:, None, None]), 0.0)
    q_dec = jnp.exp((pos + 1.0)[None, :] * lg[:, None])
    k_dec = jnp.exp((RET_CHUNK - 1.0 - pos)[None, :] * lg[:, None])
    chunk_dec = jnp.exp(RET_CHUNK * lg)

    def to_chunks(a):
        return jnp.moveaxis(a.reshape(b, h, nc, RET_CHUNK, a.shape[-1]), 2, 0)

    def step(state, qkv):
        qc, kc, vc = qkv
        s = jnp.einsum('bhnd,bhmd->bhnm', qc, kc) * decay
        o = (jnp.einsum('bhnm,bhmv->bhnv', s, vc)
             + jnp.einsum('bhnd,bhdv->bhnv', qc, state) * q_dec[..., None])
        state = (state * chunk_dec[:, None, None]
                 + jnp.einsum('bhmd,bhmv->bhdv', kc * k_dec[..., None], vc))
        return state, o

    state0 = jnp.zeros((b, h, q.shape[-1], v.shape[-1]), jnp.float32)
    _, o = lax.scan(step, state0, (to_chunks(q), to_chunks(k), to_chunks(v)))
    return jnp.moveaxis(o, 0, 2).reshape(b, h, t, v.shape[-1])


def retention_layer(h, g_norm, w_in, gn_gain, w_out):
    b, t, _ = h.shape
    proj = rmsnorm(h, g_norm) @ w_in
    q, k, v, gate = jnp.split(proj, [RET_QK_W, 2 * RET_QK_W, 2 * RET_QK_W + RET_V_W], axis=-1)

    def heads(a, d):
        return a.reshape(b, t, RET_HEADS, d).transpose(0, 2, 1, 3).astype(jnp.float32)

    pos = jnp.arange(t)
    q = rotary(heads(q, RET_QK_DIM), pos)
    k = rotary(heads(k, RET_QK_DIM), pos) * (RET_QK_DIM ** -0.5)
    o = retention_chunkwise(q, k, heads(v, RET_V_DIM))
    mu = jnp.mean(o, axis=-1, keepdims=True)
    var = jnp.mean(jnp.square(o - mu), axis=-1, keepdims=True)
    o = ((o - mu) * lax.rsqrt(var + EPS)).transpose(0, 2, 1, 3).reshape(b, t, RET_V_W)
    o = o * gn_gain.astype(jnp.float32)
    y = (jax.nn.silu(gate.astype(jnp.float32)) * o).astype(h.dtype) @ w_out
    return h + y


def per_layer_embedding(h, p_i, g, w_gate, w_emb):
    gate = jax.nn.sigmoid(rmsnorm(h, g) @ w_gate)
    return h + gate * (p_i @ w_emb)


def compress_blocks(a, pe, w1, w2):
    b, g, t, d = a.shape
    lc = CMP_LEN // CMP_STRIDE
    n_cmp = (t - CMP_LEN) // CMP_STRIDE + 1
    sub = a.reshape(b, g, t // CMP_STRIDE, CMP_STRIDE, d)
    blocks = jnp.concatenate([sub[:, :, o:o + n_cmp] for o in range(lc)], axis=3)
    blocks = (blocks + pe).reshape(b, g, n_cmp, CMP_LEN * d)
    return jax.nn.gelu(blocks @ w1) @ w2


def nsa_shared_kv(h, g_kv, w_kv, pe_k, w1_k, w2_k, pe_v, w1_v, w2_v):
    b, t, _ = h.shape
    proj = rmsnorm(h, g_kv) @ w_kv
    parts = proj.reshape(b, t, 6, NSA_GROUPS, NSA_DK).transpose(2, 0, 3, 1, 4)
    kc, vc, ks, vs, kw, vw = parts[0], parts[1], parts[2], parts[3], parts[4], parts[5]
    k_cmp = compress_blocks(kc, pe_k, w1_k, w2_k)
    v_cmp = compress_blocks(vc, pe_v, w1_v, w2_v)
    nslc = t // SEL_BLOCK
    k_sel = ks.reshape(b, NSA_GROUPS, nslc, SEL_BLOCK * NSA_DK)
    v_sel = vs.reshape(b, NSA_GROUPS, nslc, SEL_BLOCK * NSA_DV)
    pad = ((0, 0), (0, 0), (WIN, 0), (0, 0))
    return (k_cmp, v_cmp, k_sel, v_sel, jnp.pad(kw, pad), jnp.pad(vw, pad))


def selection_importance(p, nslc):
    f = SEL_BLOCK // CMP_STRIDE
    lc = CMP_LEN // CMP_STRIDE
    left = lc - 1
    right = f * nslc - p.shape[-1]
    pp = jnp.pad(p, ((0, 0), (0, 0), (0, 0), (left, right)))
    terms = []
    for o in range(-(lc - 1), f):
        w = float(min(o + lc, f) - max(o, 0))
        s = left + o
        terms.append(w * pp[..., s:s + f * (nslc - 1) + 1:f])
    return sum(terms[1:], terms[0])


def nsa_query_block(q, gates, blk, k_cmp, v_cmp, k_sel, v_sel, k_win, v_win):
    b = q.shape[0]
    scale = NSA_DK ** -0.5
    t = blk * Q_BLOCK + jnp.arange(Q_BLOCK)

    n_cmp = k_cmp.shape[2]
    cmp_end = jnp.arange(n_cmp) * CMP_STRIDE + CMP_LEN - 1
    valid_c = cmp_end[None, :] <= t[:, None]
    s_c = jnp.einsum('bgrqd,bgnd->bgrqn', q, k_cmp).astype(jnp.float32) * scale
    p_c = jnp.where(valid_c, jax.nn.softmax(jnp.where(valid_c, s_c, NEG), axis=-1), 0.0)
    o_c = jnp.einsum('bgrqn,bgnd->bgrqd', p_c, v_cmp.astype(jnp.float32))

    nslc = k_sel.shape[2]
    n_top = min(N_SEL, nslc)
    imp = selection_importance(jnp.sum(p_c, axis=2), nslc)
    cur = (t // SEL_BLOCK)[:, None]
    j = jnp.arange(nslc)[None, :]
    forced = (j == 0) | (j == cur) | (j == cur - 1)
    score = jnp.where(j <= cur, jnp.where(forced, BIG, imp), -BIG)
    top_v, top_i = lax.top_k(score, n_top)
    sel_ok = top_v > -0.5 * BIG
    idx = top_i.reshape(b, NSA_GROUPS, Q_BLOCK * n_top)
    bi = jnp.arange(b)[:, None, None]
    gi = jnp.arange(NSA_GROUPS)[None, :, None]
    ks = k_sel[bi, gi, idx].reshape(b, NSA_GROUPS, Q_BLOCK, n_top, SEL_BLOCK, NSA_DK)
    vs = v_sel[bi, gi, idx].reshape(b, NSA_GROUPS, Q_BLOCK, n_top, SEL_BLOCK, NSA_DV)
    kpos = top_i[..., None] * SEL_BLOCK + jnp.arange(SEL_BLOCK)
    valid_s = (sel_ok[..., None] & (kpos <= t[:, None, None]))[:, :, None]
    s_s = jnp.einsum('bgrqd,bgqnkd->bgrqnk', q, ks).astype(jnp.float32) * scale
    p_s = jnp.where(valid_s, jax.nn.softmax(jnp.where(valid_s, s_s, NEG), axis=(-2, -1)), 0.0)
    o_s = jnp.einsum('bgrqnk,bgqnkd->bgrqd', p_s, vs.astype(jnp.float32))

    start = blk * Q_BLOCK
    kw = lax.dynamic_slice_in_dim(k_win, start, WIN + Q_BLOCK, axis=2)
    vw = lax.dynamic_slice_in_dim(v_win, start, WIN + Q_BLOCK, axis=2)
    kwpos = start - WIN + jnp.arange(WIN + Q_BLOCK)
    valid_w = ((kwpos[None, :] <= t[:, None]) & (kwpos[None, :] > t[:, None] - WIN)
               & (kwpos[None, :] >= 0))
    s_w = jnp.einsum('bgrqd,bgkd->bgrqk', q, kw).astype(jnp.float32) * scale
    p_w = jax.nn.softmax(jnp.where(valid_w, s_w, NEG), axis=-1)
    o_w = jnp.einsum('bgrqk,bgkd->bgrqd', p_w, vw.astype(jnp.float32))

    return gates[..., 0:1] * o_c + gates[..., 1:2] * o_s + gates[..., 2:3] * o_w


def nsa_layer(h, g_norm, w_in, w_out, k_cmp, v_cmp, k_sel, v_sel, k_win, v_win):
    b, t, _ = h.shape
    proj = rmsnorm(h, g_norm) @ w_in
    q_w = NSA_HEADS * NSA_DK
    q, gate, bgate = jnp.split(proj, [q_w, q_w + NSA_W], axis=-1)
    nqb = t // Q_BLOCK
    qb = q.reshape(b, nqb, Q_BLOCK, NSA_GROUPS, NSA_HPG, NSA_DK).transpose(1, 0, 3, 4, 2, 5)
    gb = jax.nn.sigmoid(bgate.astype(jnp.float32)).reshape(
        b, nqb, Q_BLOCK, NSA_GROUPS, NSA_HPG, 3).transpose(1, 0, 3, 4, 2, 5)

    def body(args):
        q_blk, g_blk, blk = args
        return nsa_query_block(q_blk, g_blk, blk, k_cmp, v_cmp, k_sel, v_sel, k_win, v_win)

    o = lax.map(body, (qb, gb, jnp.arange(nqb)))
    o = o.transpose(1, 0, 4, 2, 3, 5).reshape(b, t, NSA_W)
    y = (jax.nn.silu(gate.astype(jnp.float32)) * o).astype(h.dtype) @ w_out
    return h + y


def setup_inputs(seed: int = 0) -> dict:
    key = jax.random.key(seed)
    ks = jax.random.split(key, 24)

    def nrm(k, shape, scale):
        return jax.random.normal(k, shape, jnp.float32) * scale

    def gain(k, shape):
        return 1.0 + 0.02 * jax.random.normal(k, shape, jnp.float32)

    ret_in_w = 2 * RET_QK_W + 2 * RET_V_W
    nsa_in_w = NSA_HEADS * NSA_DK + NSA_W + 3 * NSA_HEADS
    return {
        "x": nrm(ks[0], (BATCH, SEQ, D_MODEL), 1.0),
        "p": nrm(ks[1], (DEPTH, BATCH, SEQ, PLE_DIM), 1.0),
        "ret_norm": gain(ks[2], (N_A, D_MODEL)),
        "ret_w_in": nrm(ks[3], (N_A, D_MODEL, ret_in_w), D_MODEL ** -0.5),
        "ret_gn": gain(ks[4], (N_A, RET_V_W)),
        "ret_w_out": nrm(ks[5], (N_A, RET_V_W, D_MODEL), RET_V_W ** -0.5),
        "kv_norm": gain(ks[6], (D_MODEL,)),
        "kv_w": nrm(ks[7], (D_MODEL, 6 * NSA_KV_W), D_MODEL ** -0.5),
        "cmp_pe_k": nrm(ks[8], (CMP_LEN, NSA_DK), 0.02),
        "cmp_w1_k": nrm(ks[9], (CMP_LEN * NSA_DK, CMP_HIDDEN), (CMP_LEN * NSA_DK) ** -0.5),
        "cmp_w2_k": nrm(ks[10], (CMP_HIDDEN, NSA_DK), CMP_HIDDEN ** -0.5),
        "cmp_pe_v": nrm(ks[11], (CMP_LEN, NSA_DV), 0.02),
        "cmp_w1_v": nrm(ks[12], (CMP_LEN * NSA_DV, CMP_HIDDEN), (CMP_LEN * NSA_DV) ** -0.5),
        "cmp_w2_v": nrm(ks[13], (CMP_HIDDEN, NSA_DV), CMP_HIDDEN ** -0.5),
        "nsa_norm": gain(ks[14], (N_B, D_MODEL)),
        "nsa_w_in": nrm(ks[15], (N_B, D_MODEL, nsa_in_w), D_MODEL ** -0.5),
        "nsa_w_out": nrm(ks[16], (N_B, NSA_W, D_MODEL), NSA_W ** -0.5),
        "ple_norm": gain(ks[17], (DEPTH, D_MODEL)),
        "ple_w_gate": nrm(ks[18], (DEPTH, D_MODEL, D_MODEL), D_MODEL ** -0.5),
        "ple_w_emb": nrm(ks[19], (DEPTH, PLE_DIM, D_MODEL), PLE_DIM ** -0.5),
        "final_norm": gain(ks[20], (D_MODEL,)),
    }


def reference(x, p, ret_norm, ret_w_in, ret_gn, ret_w_out, kv_norm, kv_w,
              cmp_pe_k, cmp_w1_k, cmp_w2_k, cmp_pe_v, cmp_w1_v, cmp_w2_v,
              nsa_norm, nsa_w_in, nsa_w_out, ple_norm, ple_w_gate, ple_w_emb, final_norm):
    h = x
    shared = None
    for i in range(DEPTH):
        if i < N_A:
            h = retention_layer(h, ret_norm[i], ret_w_in[i], ret_gn[i], ret_w_out[i])
        else:
            if i == N_A:
                shared = nsa_shared_kv(h, kv_norm, kv_w, cmp_pe_k, cmp_w1_k, cmp_w2_k,
                                       cmp_pe_v, cmp_w1_v, cmp_w2_v)
            j = i - N_A
            h = nsa_layer(h, nsa_norm[j], nsa_w_in[j], nsa_w_out[j], *shared)
        h = per_layer_embedding(h, p[i], ple_norm[i], ple_w_gate[i], ple_w_emb[i])
    return rmsnorm(h, final_norm)
```

```cpp
#include <hip/hip_runtime.h>
#include <hip/hip_cooperative_groups.h>
#include <cstdio>
namespace cg = cooperative_groups;

#ifndef MEGA
#define MEGA 1
#endif

typedef unsigned short u16;
typedef unsigned int u32;
using bf16x8 = __attribute__((ext_vector_type(8))) short;
using f32x4 = __attribute__((ext_vector_type(4))) float;
#define DI __device__ __forceinline__
#define MFMA(a, b, c) __builtin_amdgcn_mfma_f32_16x16x32_bf16((a), (b), (c), 0, 0, 0)

constexpr int T = 16384, M = 32768;
constexpr long MiB = 1l << 20;
constexpr long W_RET_IN = 0;
constexpr long W_RET_OUT = W_RET_IN + 6144l * 1024;
constexpr long W_KV = W_RET_OUT + 1024l * 2048;
constexpr long W_C1K = W_KV + 3072l * 1024;
constexpr long W_C1V = W_C1K + 256l * 4096;
constexpr long W_C2K = W_C1V + 256l * 4096;
constexpr long W_C2V = W_C2K + 128l * 256;
constexpr long W_NSA = W_C2V + 128l * 256;
constexpr long W_NSA_OUT = W_NSA + 4224l * 1024;
constexpr long W_PG = W_NSA_OUT + 1024l * 2048;
constexpr long W_PE = W_PG + 2l * 1024 * 1024;
constexpr long W_END = W_PE + 2l * 1024 * 256;
static_assert(W_END * 2 < 47 * MiB, "weights region");
constexpr long OFF_BIAS = 47 * MiB;
constexpr long OFF_XB = 48 * MiB, OFF_RS = 112 * MiB, OFF_STATS = 113 * MiB;
constexpr long OFF_Q = 114 * MiB, OFF_K = 178 * MiB, OFF_KTD = 242 * MiB, OFF_VT = 306 * MiB, OFF_P = 434 * MiB;
constexpr long OFF_A2 = OFF_Q;
constexpr long OFF_KV = 114 * MiB;
constexpr long OFF_QN = 306 * MiB;
constexpr long OFF_GATES = 48 * MiB, OFF_KCMP = 54 * MiB, OFF_VCMPT = 56 * MiB, OFF_H = 58 * MiB;
constexpr long OFF_XB2 = 434 * MiB;
constexpr long OFF_SSQ1 = OFF_RS + 128 * 1024, OFF_SSQ2 = OFF_RS + 256 * 1024, OFF_SSQ3 = OFF_RS + 384 * 1024;
constexpr long WS_NEED = 498 * MiB;

struct Params {
  const float *x, *p, *ret_norm, *ret_w_in, *ret_gn, *ret_w_out, *kv_norm, *kv_w, *cmp_pe_k, *cmp_w1_k, *cmp_w2_k,
      *cmp_pe_v, *cmp_w1_v, *cmp_w2_v, *nsa_norm, *nsa_w_in, *nsa_w_out, *ple_norm, *ple_w_gate, *ple_w_emb, *final_norm;
  float* out;
  char* ws;
};

DI int my_tid() {
  int t = threadIdx.x;
  asm volatile("" : "+v"(t));
  return t;
}
DI float xmax32(float x) {
  auto r = __builtin_amdgcn_permlane32_swap(__float_as_uint(x), __float_as_uint(x), false, false);
  return fmaxf(__uint_as_float(r[0]), __uint_as_float(r[1]));
}
DI float xmax16(float x) {
  auto r = __builtin_amdgcn_permlane16_swap(__float_as_uint(x), __float_as_uint(x), false, false);
  return fmaxf(__uint_as_float(r[0]), __uint_as_float(r[1]));
}
DI float xsum32(float x) {
  auto r = __builtin_amdgcn_permlane32_swap(__float_as_uint(x), __float_as_uint(x), false, false);
  return __uint_as_float(r[0]) + __uint_as_float(r[1]);
}
DI float xsum16(float x) {
  auto r = __builtin_amdgcn_permlane16_swap(__float_as_uint(x), __float_as_uint(x), false, false);
  return __uint_as_float(r[0]) + __uint_as_float(r[1]);
}
DI float dpp_xor1(float x) { return __int_as_float(__builtin_amdgcn_update_dpp(0, __float_as_int(x), 0xB1, 0xF, 0xF, true)); }
DI float dpp_xor2(float x) { return __int_as_float(__builtin_amdgcn_update_dpp(0, __float_as_int(x), 0x4E, 0xF, 0xF, true)); }

DI void lds_barrier() { asm volatile("s_waitcnt lgkmcnt(0)\n\ts_barrier" ::: "memory"); }
DI float4 ld_nt4(const float* p) {
  const f32x4 v = __builtin_nontemporal_load((const f32x4*)p);
  return make_float4(v[0], v[1], v[2], v[3]);
}
DI void st_nt4(float* p, float4 v) { __builtin_nontemporal_store(f32x4{v.x, v.y, v.z, v.w}, (f32x4*)p); }

DI u16 f2bf(float x) {
  u32 u = __float_as_uint(x);
  u += 0x7fffu + ((u >> 16) & 1u);
  return (u16)(u >> 16);
}
DI float bf2f(u16 h) { return __uint_as_float(((u32)h) << 16); }
DI u32 pack2(float a, float b) { return (u32)f2bf(a) | ((u32)f2bf(b) << 16); }
DI u32 pack2h(float a, float b) {
  u32 r;
  asm("v_cvt_pk_bf16_f32 %0, %1, %2" : "=v"(r) : "v"(a), "v"(b));
  return r;
}
DI uint2 pack4h(float a, float b, float c, float d) { return make_uint2(pack2h(a, b), pack2h(c, d)); }
DI uint2 pack4(float a, float b, float c, float d) { return make_uint2(pack2(a, b), pack2(c, d)); }
DI float sigmoidf_(float x) { return __builtin_amdgcn_rcpf(1.f + __expf(-x)); }
DI u16* wsW(const Params& p) { return (u16*)p.ws; }

struct ConvJob {
  const float* src;
  const float* gain;
  u16* dst;
  int K, N, mode, ntn;
};
DI ConvJob get_job(const Params& p, int j) {
  ConvJob c;
  u16* W = wsW(p);
  c.gain = nullptr;
  c.mode = 0;
  switch (j) {
    case 0: c.src = p.ret_w_in; c.gain = p.ret_norm; c.dst = W + W_RET_IN; c.K = 1024; c.N = 6144; c.mode = 1; break;
    case 1: c.src = p.ret_w_out; c.dst = W + W_RET_OUT; c.K = 2048; c.N = 1024; break;
    case 2: c.src = p.kv_w; c.gain = p.kv_norm; c.dst = W + W_KV; c.K = 1024; c.N = 3072; break;
    case 3: c.src = p.cmp_w1_k; c.dst = W + W_C1K; c.K = 4096; c.N = 256; break;
    case 4: c.src = p.cmp_w1_v; c.dst = W + W_C1V; c.K = 4096; c.N = 256; break;
    case 5: c.src = p.cmp_w2_k; c.dst = W + W_C2K; c.K = 256; c.N = 128; break;
    case 6: c.src = p.cmp_w2_v; c.dst = W + W_C2V; c.K = 256; c.N = 128; break;
    case 7: c.src = p.nsa_w_in; c.gain = p.nsa_norm; c.dst = W + W_NSA; c.K = 1024; c.N = 4144; c.mode = 2; break;
    case 8: c.src = p.nsa_w_out; c.dst = W + W_NSA_OUT; c.K = 2048; c.N = 1024; break;
    case 9: c.src = p.ple_w_gate; c.gain = p.ple_norm; c.dst = W + W_PG; c.K = 1024; c.N = 1024; break;
    case 10: c.src = p.ple_w_gate + 1024l * 1024; c.gain = p.ple_norm + 1024; c.dst = W + W_PG + 1024l * 1024; c.K = 1024; c.N = 1024; break;
    case 11: c.src = p.ple_w_emb; c.dst = W + W_PE; c.K = 256; c.N = 1024; break;
    default: c.src = p.ple_w_emb + 256l * 1024; c.dst = W + W_PE + 1024l * 256; c.K = 256; c.N = 1024; break;
  }
  c.ntn = (c.N + 63) >> 6;
  return c;
}
DI int conv_ntiles(int j) {
  switch (j) {
    case 0: return 16 * 96;
    case 1: return 32 * 16;
    case 2: return 16 * 48;
    case 3: case 4: return 64 * 4;
    case 5: case 6: return 4 * 2;
    case 7: return 16 * 65;
    case 8: return 32 * 16;
    case 9: case 10: return 16 * 16;
    default: return 4 * 16;
  }
}
constexpr int CONV_TILES = 1536 + 512 + 768 + 512 + 16 + 1040 + 512 + 512 + 128;

DI int conv_dst_row(int mode, int n) {
  if (mode == 1) {
    if (n >= 2048) return n;
    int part = n >> 10, nn = n & 1023, head = nn >> 8, d = nn & 255, s = d >> 7, i = d & 127;
    return part * 1024 + head * 256 + 32 * (i >> 4) + 16 * s + (i & 15);
  } else if (mode == 2) {
    if (n < 2048) return n;
    if (n < 4096) return 2176 + (n - 2048);
    return 2048 + (n - 4096);
  }
  return n;
}

DI void conv_tile(const Params& p, int tile, char* smem) {
  int j = 0;
  for (; j < 12; ++j) {
    int nt = conv_ntiles(j);
    if (tile < nt) break;
    tile -= nt;
  }
  ConvJob cj = get_job(p, j);
  const int tk = tile / cj.ntn, tn = tile % cj.ntn;
  const int k0 = tk * 64, n0 = tn * 64;
  float* tl = (float*)smem;
  const int tid = my_tid();
  {
    const int r = tid >> 4, c4 = tid & 15;
    const int n = n0 + 4 * c4;
#pragma unroll
    for (int i = 0; i < 4; ++i) {
      const int k = r + 16 * i;
      float4 v = make_float4(0.f, 0.f, 0.f, 0.f);
      if (n < cj.N) v = ld_nt4(cj.src + (long)(k0 + k) * cj.N + n);
      float* d = tl + k * 65 + 4 * c4;
      d[0] = v.x; d[1] = v.y; d[2] = v.z; d[3] = v.w;
    }
  }
  __syncthreads();
  {
    const int nn = tid >> 2, kq = tid & 3;
    const int n = n0 + nn;
    if (n < cj.N) {
      const int row = conv_dst_row(cj.mode, n);
      u32 o[8];
#pragma unroll
      for (int i = 0; i < 8; ++i) {
        const int k = 16 * kq + 2 * i;
        float a = tl[k * 65 + nn], b = tl[(k + 1) * 65 + nn];
        if (cj.gain) { a *= cj.gain[k0 + k]; b *= cj.gain[k0 + k + 1]; }
        o[i] = pack2(a, b);
      }
      uint4* dst = (uint4*)(cj.dst + (long)row * cj.K + k0 + 16 * kq);
      dst[0] = make_uint4(o[0], o[1], o[2], o[3]);
      dst[1] = make_uint4(o[4], o[5], o[6], o[7]);
    }
  }
  __syncthreads();
}

DI void bias_item(const Params& p, int item, char* smem) {
  const int kind = item >> 5, kq = item & 31;
  const float* pe = kind ? p.cmp_pe_v : p.cmp_pe_k;
  const float* w1 = kind ? p.cmp_w1_v : p.cmp_w1_k;
  const int n = my_tid();
  float s0 = 0.f, s1 = 0.f, s2 = 0.f, s3 = 0.f;
#pragma unroll 8
  for (int k = kq * 128; k < (kq + 1) * 128; k += 4) {
    s0 += pe[k] * w1[(long)k * 256 + n];
    s1 += pe[k + 1] * w1[(long)(k + 1) * 256 + n];
    s2 += pe[k + 2] * w1[(long)(k + 2) * 256 + n];
    s3 += pe[k + 3] * w1[(long)(k + 3) * 256 + n];
  }
  ((float*)(p.ws + OFF_BIAS))[(kind * 32 + kq) * 256 + n] = (s0 + s1) + (s2 + s3);
}

DI void rownorm_item(const Params& p, const float* h, int item) {
  const int l = my_tid() & 63, w = my_tid() >> 6;
  const int row = item * 4 + w;
  const float* src = h + (long)row * 1024;
  u16* xb = (u16*)(p.ws + OFF_XB) + (long)row * 1024;
  float ss = 0.f;
#pragma unroll
  for (int i = 0; i < 4; ++i) {
    float4 v = *(const float4*)(src + 256 * i + 4 * l);
    ss += v.x * v.x + v.y * v.y + v.z * v.z + v.w * v.w;
    *(uint2*)(xb + 256 * i + 4 * l) = pack4(v.x, v.y, v.z, v.w);
  }
#pragma unroll
  for (int o = 32; o >= 1; o >>= 1) ss += __shfl_xor(ss, o);
  if (l == 0) ((float*)(p.ws + OFF_RS))[row] = rsqrtf(ss * (1.f / 1024.f) + 1e-6f);
}

DI void finalnorm_item(const Params& p, int item) {
  const int l = my_tid() & 63, w = my_tid() >> 6;
  const int row = item * 4 + w;
  float* src = p.out + (long)row * 1024;
  float4 v[4];
  float ss = 0.f;
#pragma unroll
  for (int i = 0; i < 4; ++i) {
    v[i] = ld_nt4(src + 256 * i + 4 * l);
    ss += v[i].x * v[i].x + v[i].y * v[i].y + v[i].z * v[i].z + v[i].w * v[i].w;
  }
#pragma unroll
  for (int o = 32; o >= 1; o >>= 1) ss += __shfl_xor(ss, o);
  const float rs = rsqrtf(ss * (1.f / 1024.f) + 1e-6f);
#pragma unroll
  for (int i = 0; i < 4; ++i) {
    float4 gg = *(const float4*)(p.final_norm + 256 * i + 4 * l);
    float4 o = make_float4(v[i].x * rs * gg.x, v[i].y * rs * gg.y, v[i].z * rs * gg.z, v[i].w * rs * gg.w);
    st_nt4(src + 256 * i + 4 * l, o);
  }
}

DI void stats_item(const Params& p, int item) {
  const int l = my_tid() & 63, w = my_tid() >> 6;
  const int row = item * 4 + w;
  const u16* o = (const u16*)p.out + (long)row * 2048 + 32 * l;
  float v[32];
#pragma unroll
  for (int i = 0; i < 4; ++i) {
    uint4 q = *(const uint4*)(o + 8 * i);
    u32 u[4] = {q.x, q.y, q.z, q.w};
#pragma unroll
    for (int e = 0; e < 4; ++e) {
      v[8 * i + 2 * e] = __uint_as_float(u[e] << 16);
      v[8 * i + 2 * e + 1] = __uint_as_float(u[e] & 0xffff0000u);
    }
  }
  float s = 0.f;
#pragma unroll
  for (int i = 0; i < 32; ++i) s += v[i];
#pragma unroll
  for (int o2 = 8; o2 >= 1; o2 >>= 1) s += __shfl_xor(s, o2);
  const float mu = s * (1.f / 512.f);
  float q2 = 0.f;
#pragma unroll
  for (int i = 0; i < 32; ++i) { float d = v[i] - mu; q2 += d * d; }
#pragma unroll
  for (int o2 = 8; o2 >= 1; o2 >>= 1) q2 += __shfl_xor(q2, o2);
  if ((l & 15) == 0) {
    float* st = (float*)(p.ws + OFF_STATS) + ((long)row * 4 + (l >> 4)) * 2;
    st[0] = mu;
    st[1] = rsqrtf(q2 * (1.f / 512.f) + 1e-6f);
  }
}

template <bool AF32, bool SWAP = false>
DI void gemm_main(const void* Abase, long lda, int a_valid, const u16* Bt, long ldb, int K, f32x4 (&acc)[4][4], char* smem) {
  const int tid = my_tid(), l = tid & 63, w = tid >> 6, c = l & 15, g = l >> 4;
  const int wr = w >> 1, wc = w & 1;
  const int lr = tid >> 2, lc = tid & 3;
  u16* As = (u16*)smem;
  u16* Bs = As + 2 * 128 * 32;
  const int wsw = (lc ^ ((0 - (lr >> 2)) & 3)) * 8;
  const int rsw = (g ^ ((0 - (c >> 2)) & 3)) * 8;
  const int ar0 = min(lr, a_valid - 1), ar1 = min(lr + 64, a_valid - 1);
  const u16* bp0 = Bt + (long)lr * ldb + lc * 8;
  const u16* bp1 = Bt + (long)(lr + 64) * ldb + lc * 8;
  uint4 ra0, ra1, rb0, rb1;
#define GEMM_LOAD(k0)                                                                  \
  {                                                                                    \
    if (AF32) {                                                                        \
      const float* a0 = (const float*)Abase + (long)ar0 * lda + (k0) + lc * 8;         \
      const float* a1 = (const float*)Abase + (long)ar1 * lda + (k0) + lc * 8;         \
      float4 x0 = ld_nt4(a0), x1 = ld_nt4(a0 + 4);                                     \
      float4 y0 = ld_nt4(a1), y1 = ld_nt4(a1 + 4);                                     \
      ra0 = make_uint4(pack2(x0.x, x0.y), pack2(x0.z, x0.w), pack2(x1.x, x1.y), pack2(x1.z, x1.w)); \
      ra1 = make_uint4(pack2(y0.x, y0.y), pack2(y0.z, y0.w), pack2(y1.x, y1.y), pack2(y1.z, y1.w)); \
    } else {                                                                           \
      ra0 = *(const uint4*)((const u16*)Abase + (long)ar0 * lda + (k0) + lc * 8);      \
      ra1 = *(const uint4*)((const u16*)Abase + (long)ar1 * lda + (k0) + lc * 8);      \
    }                                                                                  \
    rb0 = *(const uint4*)(bp0 + (k0));                                                 \
    rb1 = *(const uint4*)(bp1 + (k0));                                                 \
  }
#define GEMM_STORE(buf)                                                 \
  {                                                                     \
    *(uint4*)(As + ((buf) * 128 + lr) * 32 + wsw) = ra0;             \
    *(uint4*)(As + ((buf) * 128 + lr + 64) * 32 + wsw) = ra1;        \
    *(uint4*)(Bs + ((buf) * 128 + lr) * 32 + wsw) = rb0;             \
    *(uint4*)(Bs + ((buf) * 128 + lr + 64) * 32 + wsw) = rb1;        \
  }
#pragma unroll
  for (int i = 0; i < 4; ++i)
#pragma unroll
    for (int j = 0; j < 4; ++j) acc[i][j] = f32x4{0.f, 0.f, 0.f, 0.f};
#define GEMM_COMPUTE(buf)                                                                                   \
  {                                                                                                         \
    bf16x8 af[4], bfr[4];                                                                                   \
    _Pragma("unroll") for (int i = 0; i < 4; ++i) {                                                         \
      af[i] = *(const bf16x8*)(As + ((buf) * 128 + 64 * wr + 16 * i + c) * 32 + rsw);                       \
      bfr[i] = *(const bf16x8*)(Bs + ((buf) * 128 + 64 * wc + 16 * i + c) * 32 + rsw);                      \
    }                                                                                                       \
    __builtin_amdgcn_s_setprio(1);                                                                          \
    _Pragma("unroll") for (int i = 0; i < 4; ++i)                                                           \
      _Pragma("unroll") for (int j = 0; j < 4; ++j)                                                         \
        acc[i][j] = SWAP ? MFMA(bfr[j], af[i], acc[i][j]) : MFMA(af[i], bfr[j], acc[i][j]);                 \
    __builtin_amdgcn_s_setprio(0);                                                                          \
    __builtin_amdgcn_sched_group_barrier(0x100, 8, 0);                                                      \
    __builtin_amdgcn_sched_group_barrier(0x008, 16, 0);                                                     \
  }
  const int nk = K >> 5;
  if (AF32) {
    GEMM_LOAD(0);
    GEMM_STORE(0);
    __syncthreads();
    for (int kt = 0; kt < nk; ++kt) {
      const int buf = kt & 1;
      GEMM_LOAD(min((kt + 1) * 32, K - 32));
      GEMM_COMPUTE(buf);
      GEMM_STORE(buf ^ 1);
      __syncthreads();
    }
  } else {
    uint4 sa0, sa1, sb0, sb1;
#define GEMM_LOAD2(k0)                                                              \
  {                                                                                 \
    sa0 = *(const uint4*)((const u16*)Abase + (long)ar0 * lda + (k0) + lc * 8);     \
    sa1 = *(const uint4*)((const u16*)Abase + (long)ar1 * lda + (k0) + lc * 8);     \
    sb0 = *(const uint4*)(bp0 + (k0));                                              \
    sb1 = *(const uint4*)(bp1 + (k0));                                              \
  }
#define GEMM_STORE2(buf)                                          \
  {                                                               \
    *(uint4*)(As + ((buf) * 128 + lr) * 32 + wsw) = sa0;          \
    *(uint4*)(As + ((buf) * 128 + lr + 64) * 32 + wsw) = sa1;     \
    *(uint4*)(Bs + ((buf) * 128 + lr) * 32 + wsw) = sb0;          \
    *(uint4*)(Bs + ((buf) * 128 + lr + 64) * 32 + wsw) = sb1;     \
  }
    const int klast = K - 32;
    GEMM_LOAD(0);
    GEMM_LOAD2(32);
    GEMM_STORE(0);
    __syncthreads();
    for (int kt = 0; kt < nk; kt += 2) {
      GEMM_LOAD(min((kt + 2) * 32, klast));
      GEMM_COMPUTE(0);
      GEMM_STORE2(1);
      __syncthreads();
      GEMM_LOAD2(min((kt + 3) * 32, klast));
      GEMM_COMPUTE(1);
      GEMM_STORE(0);
      __syncthreads();
    }
#undef GEMM_LOAD2
#undef GEMM_STORE2
  }
#undef GEMM_COMPUTE
#undef GEMM_LOAD
#undef GEMM_STORE
}

#define EPI_COORDS                                                             \
  const int tid = my_tid(), l = tid & 63, w = tid >> 6, c = l & 15, g = l >> 4; \
  const int wr = w >> 1, wc = w & 1;                                           \
  const int rbase = m0 + 64 * wr + 4 * g, cbase = n0 + 64 * wc + c;

template <bool SWAP = false>
DI void gemm_main8(const u16* Abase, long lda, const u16* Bt, long ldb, int K, f32x4 (&acc)[8][4], char* smem) {
  const int tid = my_tid(), l = tid & 63, w = tid >> 6, c = l & 15, g = l >> 4;
  const int wr = w >> 1, wc = w & 1;
  const int lr = tid >> 2, lc = tid & 3;
  u16* As = (u16*)smem;
  u16* Bs = As + 2 * 256 * 32;
  const int wsw = (lc ^ ((0 - (lr >> 2)) & 3)) * 8;
  const int rsw = (g ^ ((0 - (c >> 2)) & 3)) * 8;
  const u16* ap = Abase + (long)lr * lda + lc * 8;
  const u16* bp = Bt + (long)lr * ldb + lc * 8;
  uint4 xa0, xa1, xa2, xa3, xb0, xb1;
  uint4 ya0, ya1, ya2, ya3, yb0, yb1;
#define GEMM8_LOAD(S, k0)                                \
  {                                                      \
    S##a0 = *(const uint4*)(ap + (k0));                  \
    S##a1 = *(const uint4*)(ap + 64 * lda + (k0));       \
    S##a2 = *(const uint4*)(ap + 128 * lda + (k0));      \
    S##a3 = *(const uint4*)(ap + 192 * lda + (k0));      \
    S##b0 = *(const uint4*)(bp + (k0));                  \
    S##b1 = *(const uint4*)(bp + 64 * ldb + (k0));       \
  }
#define GEMM8_STORE(S, buf)                                              \
  {                                                                      \
    *(uint4*)(As + ((buf) * 256 + lr) * 32 + wsw) = S##a0;            \
    *(uint4*)(As + ((buf) * 256 + lr + 64) * 32 + wsw) = S##a1;       \
    *(uint4*)(As + ((buf) * 256 + lr + 128) * 32 + wsw) = S##a2;      \
    *(uint4*)(As + ((buf) * 256 + lr + 192) * 32 + wsw) = S##a3;      \
    *(uint4*)(Bs + ((buf) * 128 + lr) * 32 + wsw) = S##b0;            \
    *(uint4*)(Bs + ((buf) * 128 + lr + 64) * 32 + wsw) = S##b1;       \
  }
#define GEMM8_COMPUTE(buf)                                                                        \
  {                                                                                               \
    bf16x8 bfr[4], af[8];                                                                         \
    _Pragma("unroll") for (int i = 0; i < 4; ++i) bfr[i] =                                        \
        *(const bf16x8*)(Bs + ((buf) * 128 + 64 * wc + 16 * i + c) * 32 + rsw);                   \
    _Pragma("unroll") for (int i = 0; i < 8; ++i) af[i] =                                         \
        *(const bf16x8*)(As + ((buf) * 256 + 128 * wr + 16 * i + c) * 32 + rsw);                  \
    __builtin_amdgcn_s_setprio(1);                                                                \
    _Pragma("unroll") for (int i = 0; i < 8; ++i) {                                               \
      _Pragma("unroll") for (int j = 0; j < 4; ++j) acc[i][j] = SWAP ? MFMA(bfr[j], af[i], acc[i][j]) : MFMA(af[i], bfr[j], acc[i][j]); \
    }                                                                                             \
    __builtin_amdgcn_s_setprio(0);                                                                \
    __builtin_amdgcn_sched_group_barrier(0x100, 12, 0);                                           \
    __builtin_amdgcn_sched_group_barrier(0x008, 32, 0);                                           \
  }
#pragma unroll
  for (int i = 0; i < 8; ++i)
#pragma unroll
    for (int j = 0; j < 4; ++j) acc[i][j] = f32x4{0.f, 0.f, 0.f, 0.f};
  const int nk = K >> 5;
  GEMM8_LOAD(x, 0);
  GEMM8_LOAD(y, 32);
  GEMM8_STORE(x, 0);
  __syncthreads();
  const int klast = K - 32;
  for (int kt = 0; kt < nk; kt += 2) {
    GEMM8_LOAD(x, min((kt + 2) * 32, klast));
    GEMM8_COMPUTE(0);
    GEMM8_STORE(y, 1);
    __syncthreads();
    GEMM8_LOAD(y, min((kt + 3) * 32, klast));
    GEMM8_COMPUTE(1);
    GEMM8_STORE(x, 0);
    __syncthreads();
  }
#undef GEMM8_COMPUTE
#undef GEMM8_LOAD
#undef GEMM8_STORE
}

#define EPI_COORDS8                                                            \
  const int tid = my_tid(), l = tid & 63, w = tid >> 6, c = l & 15, g = l >> 4; \
  const int wr = w >> 1, wc = w & 1;                                           \
  const int rbase = m0 + 128 * wr + 4 * g, cbase = n0 + 64 * wc + c;

#define EPI_COORDS_S(WM)                                                       \
  const int tid = my_tid(), l = tid & 63, w = tid >> 6, c = l & 15, g = l >> 4; \
  const int wr = w >> 1, wc = w & 1;                                           \
  const int rrow = m0 + (WM) * wr + c, ccol = n0 + 64 * wc + 4 * g;

DI float rs_from_ssq(const float* ssq, long m) { return rsqrtf(ssq[m] * (1.f / 1024.f) + 1e-6f); }

DI void decode_xcd(int tile, int NT, int& mt, int& nt) {
  const int xcd = tile & 7, j = tile >> 3;
  mt = (j / NT) * 8 + xcd;
  nt = j % NT;
}

DI void decode_xcd2d(int tile, int NT, int& mt, int& nt) {
  const int xcd = tile & 7, j = tile >> 3, hn = NT >> 1;
  mt = (j / hn) * 4 + (xcd >> 1);
  nt = (xcd & 1) * hn + j % hn;
}

DI float lg_head(int h) { return log1pf(-exp2f(-5.f - (float)h)); }

DI void ret_qkv_tile(const Params& p, int tile, char* smem) {
  int mt, nt;
  decode_xcd2d(tile, 32, mt, nt);
  const int m0 = mt * 256, n0 = nt * 128;
  f32x4 acc[8][4];
  gemm_main8((const u16*)(p.ws + OFF_XB) + (long)m0 * 1024, 1024, wsW(p) + W_RET_IN + (long)n0 * 1024, 1024, 1024, acc, smem);
  EPI_COORDS8
  const float* rs = (const float*)(p.ws + OFF_RS);
  if (n0 < 2048) {
    const int part = n0 >> 10, head = (n0 & 1023) >> 8;
    const int dpb = (n0 & 255) + 64 * wc;
    const float lgh = lg_head(head);
    u16* Q = (u16*)(p.ws + OFF_Q);
    u16* Kb = (u16*)(p.ws + OFF_K);
    u16* Ktd = (u16*)(p.ws + OFF_KTD);
#pragma unroll
    for (int a = 0; a < 2; ++a) {
      const int dp1 = dpb + 32 * a + c, dp2 = dp1 + 16;
      const int i = ((dpb + 32 * a) >> 1) + c;
      const float ir = exp2f(-(float)i * (13.287712379549449f / 128.0f)) * 0.15915494309189535f;
#pragma unroll
      for (int ti = 0; ti < 8; ++ti) {
        float y1[4], y2[4];
        const int mrow0 = rbase + 16 * ti;
        const int b = mrow0 >> 14;
        const int t0 = mrow0 & (T - 1);
#pragma unroll
        for (int j = 0; j < 4; ++j) {
          const int t = t0 + j;
          const float r = rs[mrow0 + j];
          const float x1 = acc[ti][2 * a][j] * r, x2 = acc[ti][2 * a + 1][j] * r;
          const float tf = (float)t;
          const float pr_ = tf * ir;
          const float er_ = fmaf(tf, ir, -pr_);
          const float rf = (pr_ - floorf(pr_)) + er_;
          const float sn = __builtin_amdgcn_sinf(rf), cs = __builtin_amdgcn_cosf(rf);
          y1[j] = x1 * cs - x2 * sn;
          y2[j] = x1 * sn + x2 * cs;
        }
        const long bh = (long)b * 4 + head;
        if (part == 0) {
#pragma unroll
          for (int j = 0; j < 4; ++j) {
            Q[(bh * T + t0 + j) * 256 + dp1] = f2bf(y1[j]);
            Q[(bh * T + t0 + j) * 256 + dp2] = f2bf(y2[j]);
          }
        } else {
          float kd[4];
#pragma unroll
          for (int j = 0; j < 4; ++j) {
            y1[j] *= 0.0625f;
            y2[j] *= 0.0625f;
            Kb[(bh * T + t0 + j) * 256 + dp1] = f2bf(y1[j]);
            Kb[(bh * T + t0 + j) * 256 + dp2] = f2bf(y2[j]);
            kd[j] = __expf((float)(127 - ((t0 + j) & 127)) * lgh);
          }
          *(uint2*)(Ktd + ((bh * 128 + (t0 >> 7)) * 256 + dp1) * 128 + (t0 & 127)) = pack4h(y1[0] * kd[0], y1[1] * kd[1], y1[2] * kd[2], y1[3] * kd[3]);
          *(uint2*)(Ktd + ((bh * 128 + (t0 >> 7)) * 256 + dp2) * 128 + (t0 & 127)) = pack4h(y2[0] * kd[0], y2[1] * kd[1], y2[2] * kd[2], y2[3] * kd[3]);
        }
        __builtin_amdgcn_sched_barrier(0);
      }
    }
  } else {
    u16* Vt = (u16*)(p.ws + OFF_VT);
#pragma unroll
    for (int ti = 0; ti < 8; ++ti) {
      const int mrow0 = rbase + 16 * ti;
      const int b = mrow0 >> 14, t0 = mrow0 & (T - 1);
      const float r0 = rs[mrow0], r1 = rs[mrow0 + 1], r2 = rs[mrow0 + 2], r3 = rs[mrow0 + 3];
#pragma unroll
      for (int tj = 0; tj < 4; ++tj) {
        const int nv = cbase + 16 * tj - 2048;
        const int head = nv >> 9, dv = nv & 511;
        *(uint2*)(Vt + ((((long)b * 4 + head) * 128 + (t0 >> 7)) * 512 + dv) * 128 + (t0 & 127)) =
            pack4h(acc[ti][tj][0] * r0, acc[ti][tj][1] * r1, acc[ti][tj][2] * r2, acc[ti][tj][3] * r3);
      }
    }
  }
}

DI void ret_p_tile(const Params& p, int z, char* smem) {
  const int bh = z >> 7, head = bh & 3;
  const u16* Q = (const u16*)(p.ws + OFF_Q) + (long)z * 128 * 256;
  const u16* Kb = (const u16*)(p.ws + OFF_K) + (long)z * 128 * 256;
  f32x4 acc[4][4];
  gemm_main<false, true>(Q, 256, 128, Kb, 256, 256, acc, smem);
  const int m0 = 0, n0 = 0;
  EPI_COORDS_S(64)
  const float lgh = lg_head(head);
  u16* P = (u16*)(p.ws + OFF_P) + (long)z * 128 * 128;
#pragma unroll
  for (int ti = 0; ti < 4; ++ti) {
    const int n = rrow + 16 * ti;
#pragma unroll
    for (int tj = 0; tj < 4; ++tj) {
      const int mb = ccol + 16 * tj;
      float v[4];
#pragma unroll
      for (int jj = 0; jj < 4; ++jj) v[jj] = (n >= mb + jj) ? acc[ti][tj][jj] * __expf((float)(n - mb - jj) * lgh) : 0.f;
      *(uint2*)(P + n * 128 + mb) = pack4h(v[0], v[1], v[2], v[3]);
    }
  }
}

DI void ret_scan_item(const Params& p, int item, char* smem) {
  const int tid = my_tid(), l = tid & 63, w = tid >> 6, c = l & 15, g = l >> 4;
  const int bh = item & 7, sl = item >> 3;
  const int b = bh >> 2, head = bh & 3;
  const int dv0 = sl * 16;
  const float lgh = lg_head(head);
  const float cdec = __expf(128.f * lgh);
  u16* S = (u16*)smem;
  for (int i = tid; i < 16 * 264; i += 256) S[i] = 0;
  __syncthreads();
  const u16* Q = (const u16*)(p.ws + OFF_Q) + (long)bh * T * 256;
  const u16* Ktd = (const u16*)(p.ws + OFF_KTD) + (long)bh * 256 * T;
  const u16* Vt = (const u16*)(p.ws + OFF_VT) + (long)bh * 512 * T + (long)(dv0 + c) * 128;
  const u16* P = (const u16*)(p.ws + OFF_P) + (long)bh * 128 * 128 * 128;
  u16* O = (u16*)p.out;
  f32x4 st[4];
#pragma unroll
  for (int i = 0; i < 4; ++i) st[i] = f32x4{0.f, 0.f, 0.f, 0.f};
  float qd[2][4];
#pragma unroll
  for (int r2 = 0; r2 < 2; ++r2)
#pragma unroll
    for (int j = 0; j < 4; ++j) qd[r2][j] = __expf((float)(32 * w + 16 * r2 + 4 * g + j + 1) * lgh);
  bf16x8 vb[4], pf[2][4], qa[2][8], kf[4][4];
#define SCAN_LOAD(chn)                                                                                          \
  {                                                                                                             \
    const int tn_ = (chn) * 128;                                                                                \
    _Pragma("unroll") for (int ks = 0; ks < 4; ++ks) vb[ks] = *(const bf16x8*)(Vt + (long)(chn) * 65536 + 32 * ks + 8 * g);     \
    _Pragma("unroll") for (int r2 = 0; r2 < 2; ++r2) {                                                          \
      const u16* pr_ = P + ((long)(chn) * 128 + 32 * w + 16 * r2 + c) * 128 + 8 * g;                            \
      _Pragma("unroll") for (int ks = 0; ks < 4; ++ks) pf[r2][ks] = *(const bf16x8*)(pr_ + 32 * ks);            \
      const u16* qr_ = Q + (long)(tn_ + 32 * w + 16 * r2 + c) * 256 + 8 * g;                                    \
      _Pragma("unroll") for (int k8 = 0; k8 < 8; ++k8) qa[r2][k8] = *(const bf16x8*)(qr_ + 32 * k8);            \
    }                                                                                                           \
    _Pragma("unroll") for (int rt = 0; rt < 4; ++rt) {                                                          \
      const u16* kr_ = Ktd + (long)(chn) * 32768 + (64 * w + 16 * rt + c) * 128 + 8 * g;                                    \
      _Pragma("unroll") for (int ks = 0; ks < 4; ++ks) kf[rt][ks] = *(const bf16x8*)(kr_ + 32 * ks);            \
    }                                                                                                           \
  }
  SCAN_LOAD(0);
  for (int ch = 0; ch < 128; ++ch) {
    const int t0 = ch * 128;
    f32x4 apv[2], aqs[2];
#pragma unroll
    for (int r2 = 0; r2 < 2; ++r2) {
      apv[r2] = f32x4{0.f, 0.f, 0.f, 0.f};
      aqs[r2] = f32x4{0.f, 0.f, 0.f, 0.f};
#pragma unroll
      for (int ks = 0; ks < 4; ++ks) apv[r2] = MFMA(pf[r2][ks], vb[ks], apv[r2]);
    }
#pragma unroll
    for (int k8 = 0; k8 < 8; ++k8) {
      const bf16x8 sb = *(const bf16x8*)(S + c * 264 + 32 * k8 + 8 * g);
#pragma unroll
      for (int r2 = 0; r2 < 2; ++r2) aqs[r2] = MFMA(qa[r2][k8], sb, aqs[r2]);
    }
#pragma unroll
    for (int rt = 0; rt < 4; ++rt) {
      st[rt] *= cdec;
#pragma unroll
      for (int ks = 0; ks < 4; ++ks) st[rt] = MFMA(kf[rt][ks], vb[ks], st[rt]);
    }
    __builtin_amdgcn_sched_barrier(0);
    SCAN_LOAD(min(ch + 1, 127));
    __builtin_amdgcn_sched_barrier(0);
#pragma unroll
    for (int r2 = 0; r2 < 2; ++r2)
#pragma unroll
      for (int j = 0; j < 4; ++j) {
        const int n = 32 * w + 16 * r2 + 4 * g + j;
        const float v = apv[r2][j] + qd[r2][j] * aqs[r2][j];
        O[((long)b * T + t0 + n) * 2048 + head * 512 + dv0 + c] = f2bf(v);
      }
    lds_barrier();
#pragma unroll
    for (int rt = 0; rt < 4; ++rt)
      *(uint2*)(S + c * 264 + 64 * w + 16 * rt + 4 * g) = pack4(st[rt][0], st[rt][1], st[rt][2], st[rt][3]);
    lds_barrier();
  }
#undef SCAN_LOAD
}

DI void ret_gate_tile(const Params& p, int tile, char* smem) {
  int mt, nt;
  decode_xcd(tile, 16, mt, nt);
  const int m0 = mt * 256, n0 = nt * 128;
  f32x4 acc[8][4];
  gemm_main8<true>((const u16*)(p.ws + OFF_XB) + (long)m0 * 1024, 1024, wsW(p) + W_RET_IN + (long)(4096 + n0) * 1024, 1024, 1024, acc, smem);
  EPI_COORDS_S(128)
  const float* rs = (const float*)(p.ws + OFF_RS);
  const float* stats = (const float*)(p.ws + OFF_STATS);
  const u16* O = (const u16*)p.out;
  u16* A2 = (u16*)(p.ws + OFF_A2);
  const int head = n0 >> 9;
  float4 gn[4];
#pragma unroll
  for (int tj = 0; tj < 4; ++tj) gn[tj] = *(const float4*)(p.ret_gn + ccol + 16 * tj);
#pragma unroll
  for (int hh = 0; hh < 2; ++hh) {
    float r[4];
    float2 st[4];
    uint2 ov[4][4];
#pragma unroll
    for (int t4 = 0; t4 < 4; ++t4) {
      const long m = rrow + 16 * (4 * hh + t4);
      r[t4] = rs[m];
      st[t4] = *(const float2*)(stats + (m * 4 + head) * 2);
#pragma unroll
      for (int tj = 0; tj < 4; ++tj) ov[t4][tj] = *(const uint2*)(O + m * 2048 + ccol + 16 * tj);
    }
    __builtin_amdgcn_sched_barrier(0);
#pragma unroll
    for (int t4 = 0; t4 < 4; ++t4) {
      const int ti = 4 * hh + t4;
      const long m = rrow + 16 * ti;
      const float mu = st[t4].x, rstd = st[t4].y;
#pragma unroll
      for (int tj = 0; tj < 4; ++tj) {
        const uint2 o = ov[t4][tj];
        const float o0 = __uint_as_float(o.x << 16), o1 = __uint_as_float(o.x & 0xffff0000u);
        const float o2 = __uint_as_float(o.y << 16), o3 = __uint_as_float(o.y & 0xffff0000u);
        const float g0 = acc[ti][tj][0] * r[t4], g1 = acc[ti][tj][1] * r[t4], g2 = acc[ti][tj][2] * r[t4], g3 = acc[ti][tj][3] * r[t4];
        *(uint2*)(A2 + m * 2048 + ccol + 16 * tj) =
            pack4h(g0 * sigmoidf_(g0) * (o0 - mu) * rstd * gn[tj].x, g1 * sigmoidf_(g1) * (o1 - mu) * rstd * gn[tj].y,
                  g2 * sigmoidf_(g2) * (o2 - mu) * rstd * gn[tj].z, g3 * sigmoidf_(g3) * (o3 - mu) * rstd * gn[tj].w);
      }
    }
    __builtin_amdgcn_sched_barrier(0);
  }
}

DI void ret_out_tile(const Params& p, int tile, char* smem) {
  int mt, nt;
  decode_xcd(tile, 8, mt, nt);
  const int m0 = mt * 256, n0 = nt * 128;
  f32x4 acc[8][4];
  gemm_main8<true>((const u16*)(p.ws + OFF_A2) + (long)m0 * 2048, 2048, wsW(p) + W_RET_OUT + (long)n0 * 2048, 2048, 2048, acc, smem);
  EPI_COORDS_S(128)
#pragma unroll
  for (int hh = 0; hh < 2; ++hh) {
    float4 xv[4][4];
#pragma unroll
    for (int t4 = 0; t4 < 4; ++t4)
#pragma unroll
      for (int tj = 0; tj < 4; ++tj) xv[t4][tj] = ld_nt4(p.x + (long)(rrow + 16 * (4 * hh + t4)) * 1024 + ccol + 16 * tj);
    __builtin_amdgcn_sched_barrier(0);
#pragma unroll
    for (int t4 = 0; t4 < 4; ++t4) {
      const int ti = 4 * hh + t4;
      const long m = rrow + 16 * ti;
      float ss = 0.f;
#pragma unroll
      for (int tj = 0; tj < 4; ++tj) {
        const int n = ccol + 16 * tj;
        const float4 h = make_float4(xv[t4][tj].x + acc[ti][tj][0], xv[t4][tj].y + acc[ti][tj][1], xv[t4][tj].z + acc[ti][tj][2],
                                     xv[t4][tj].w + acc[ti][tj][3]);
        *(float4*)(p.out + m * 1024 + n) = h;
        *(uint2*)((u16*)(p.ws + OFF_XB) + m * 1024 + n) = pack4h(h.x, h.y, h.z, h.w);
        ss += h.x * h.x + h.y * h.y + h.z * h.z + h.w * h.w;
      }
      ss = xsum16(xsum32(ss));
      if (g == 0) atomicAdd((float*)(p.ws + OFF_SSQ1) + m, ss);
    }
    __builtin_amdgcn_sched_barrier(0);
  }
}

DI void ple_tile(const Params& p, int layer, int tile, char* smem) {
  int mt, nt;
  decode_xcd(tile, 8, mt, nt);
  const int m0 = mt * 128, n0 = nt * 128;
  f32x4 ae[4][4], ag[4][4];
  gemm_main<true, true>(p.p + ((long)layer * M + m0) * 256, 256, 128, wsW(p) + W_PE + (long)layer * 1024 * 256 + (long)n0 * 256, 256, 256, ae, smem);
  gemm_main<false, true>((const u16*)(p.ws + OFF_XB) + (long)m0 * 1024, 1024, 128, wsW(p) + W_PG + (long)layer * 1024 * 1024 + (long)n0 * 1024, 1024, 1024, ag, smem);
  EPI_COORDS_S(64)
  const float* ssq_in = (const float*)(p.ws + (layer == 0 ? OFF_SSQ1 : OFF_SSQ3));
  float rq[4];
  float4 hv[4][4];
#pragma unroll
  for (int ti = 0; ti < 4; ++ti) {
    rq[ti] = ssq_in[rrow + 16 * ti];
#pragma unroll
    for (int tj = 0; tj < 4; ++tj) hv[ti][tj] = *(const float4*)(p.out + (long)(rrow + 16 * ti) * 1024 + ccol + 16 * tj);
  }
  __builtin_amdgcn_sched_barrier(0);
#pragma unroll
  for (int ti = 0; ti < 4; ++ti) {
    const long m = rrow + 16 * ti;
    const float r = rsqrtf(rq[ti] * (1.f / 1024.f) + 1e-6f);
    float ss = 0.f;
#pragma unroll
    for (int tj = 0; tj < 4; ++tj) {
      float4 h = hv[ti][tj];
      h.x += sigmoidf_(ag[ti][tj][0] * r) * ae[ti][tj][0];
      h.y += sigmoidf_(ag[ti][tj][1] * r) * ae[ti][tj][1];
      h.z += sigmoidf_(ag[ti][tj][2] * r) * ae[ti][tj][2];
      h.w += sigmoidf_(ag[ti][tj][3] * r) * ae[ti][tj][3];
      *(float4*)(p.out + m * 1024 + ccol + 16 * tj) = h;
      if (layer == 0) {
        *(uint2*)((u16*)(p.ws + OFF_XB2) + m * 1024 + ccol + 16 * tj) = pack4(h.x, h.y, h.z, h.w);
        ss += h.x * h.x + h.y * h.y + h.z * h.z + h.w * h.w;
      }
    }
    if (layer == 0) {
      ss = xsum16(xsum32(ss));
      if (g == 0) atomicAdd((float*)(p.ws + OFF_SSQ2) + m, ss);
    }
  }
}

DI u16* kvpart(const Params& p, int part) { return (u16*)(p.ws + OFF_KV + (long)part * 32 * MiB); }

DI void kv_tile(const Params& p, int tile, char* smem) {
  int mt, nt;
  decode_xcd2d(tile, 24, mt, nt);
  const int m0 = mt * 256, n0 = nt * 128;
  const float* ssq = (const float*)(p.ws + OFF_SSQ2);
  const int part = nt >> 2, grp = nt & 3;
  u16* dst = kvpart(p, part);
  const bool transposed = (part == 3) || (part == 5);
  f32x4 acc[8][4];
  if (transposed) {
    gemm_main8<false>((const u16*)(p.ws + OFF_XB2) + (long)m0 * 1024, 1024, wsW(p) + W_KV + (long)n0 * 1024, 1024, 1024, acc, smem);
    EPI_COORDS8
#pragma unroll
    for (int ti = 0; ti < 8; ++ti) {
      const int mrow0 = rbase + 16 * ti;
      const int b = mrow0 >> 14, t0 = mrow0 & (T - 1);
      const long bg = (long)b * 4 + grp;
      const float r0 = rs_from_ssq(ssq, mrow0), r1 = rs_from_ssq(ssq, mrow0 + 1), r2 = rs_from_ssq(ssq, mrow0 + 2), r3 = rs_from_ssq(ssq, mrow0 + 3);
#pragma unroll
      for (int tj = 0; tj < 4; ++tj) {
        const int d = 64 * wc + 16 * tj + c;
        *(uint2*)(dst + ((bg * 256 + (t0 >> 6)) * 128 + d) * 64 + (t0 & 63)) =
            pack4h(acc[ti][tj][0] * r0, acc[ti][tj][1] * r1, acc[ti][tj][2] * r2, acc[ti][tj][3] * r3);
      }
    }
  } else {
    gemm_main8<true>((const u16*)(p.ws + OFF_XB2) + (long)m0 * 1024, 1024, wsW(p) + W_KV + (long)n0 * 1024, 1024, 1024, acc, smem);
    EPI_COORDS_S(128)
#pragma unroll
    for (int ti = 0; ti < 8; ++ti) {
      const int m = rrow + 16 * ti;
      const int b = m >> 14, t = m & (T - 1);
      const float r = rs_from_ssq(ssq, m);
      u16* q = dst + (((long)b * 4 + grp) * T + t) * 128 + 64 * wc + 4 * g;
#pragma unroll
      for (int tj = 0; tj < 4; ++tj)
        *(uint2*)(q + 16 * tj) = pack4h(acc[ti][tj][0] * r, acc[ti][tj][1] * r, acc[ti][tj][2] * r, acc[ti][tj][3] * r);
    }
  }
}

DI void nsaq_tile(const Params& p, int tile, char* smem) {
  int mt, nt;
  decode_xcd(tile, 17, mt, nt);
  const int m0 = mt * 256, n0 = nt * 128;
  f32x4 acc[8][4];
  gemm_main8<true>((const u16*)(p.ws + OFF_XB2) + (long)m0 * 1024, 1024, wsW(p) + W_NSA + (long)n0 * 1024, 1024, 1024, acc, smem);
  EPI_COORDS_S(128)
  const float* ssq = (const float*)(p.ws + OFF_SSQ2);
  u16* Qn = (u16*)(p.ws + OFF_QN);
  float* gates = (float*)(p.ws + OFF_GATES);
  const float qscale = 0.08838834764831845f * 1.4426950408889634f;
#pragma unroll
  for (int ti = 0; ti < 8; ++ti) {
    const long m = rrow + 16 * ti;
    const float r = rs_from_ssq(ssq, m);
#pragma unroll
    for (int tj = 0; tj < 4; ++tj) {
      const int n = ccol + 16 * tj;
      const float v0 = acc[ti][tj][0] * r, v1 = acc[ti][tj][1] * r, v2 = acc[ti][tj][2] * r, v3 = acc[ti][tj][3] * r;
      if (n < 2048) *(uint2*)(Qn + m * 2048 + n) = pack4h(v0 * qscale, v1 * qscale, v2 * qscale, v3 * qscale);
      else if (n < 2096) *(float4*)(gates + m * 48 + (n - 2048)) = make_float4(sigmoidf_(v0), sigmoidf_(v1), sigmoidf_(v2), sigmoidf_(v3));
    }
  }
}

DI float gelu_tanh(float x) {
  const float u = 0.7978845608028654f * (x + 0.044715f * x * x * x);
  return 0.5f * x * (1.f + tanhf(u));
}

DI void cmp1_tile(const Params& p, int tile, char* smem) {
  const int z = tile >> 4, mt = (tile >> 1) & 7, nt = tile & 1;
  const int kind = z >> 3, bg = z & 7;
  const int m0 = mt * 128, n0 = nt * 128;
  const u16* A = kvpart(p, kind) + (long)bg * T * 128 + (long)m0 * 2048;
  f32x4 acc[4][4];
  gemm_main<false>(A, 2048, 1023 - m0, wsW(p) + (kind ? W_C1V : W_C1K) + (long)n0 * 4096, 4096, 4096, acc, smem);
  EPI_COORDS
  const float* bpart = (const float*)(p.ws + OFF_BIAS) + kind * 32 * 256;
  u16* H = (u16*)(p.ws + OFF_H) + (long)z * 1024 * 256;
  float bias[4];
#pragma unroll
  for (int tj = 0; tj < 4; ++tj) {
    float bs = 0.f;
    for (int q = 0; q < 32; ++q) bs += bpart[q * 256 + cbase + 16 * tj];
    bias[tj] = bs;
  }
#pragma unroll
  for (int ti = 0; ti < 4; ++ti)
#pragma unroll
    for (int j = 0; j < 4; ++j) {
      const int m = rbase + 16 * ti + j;
#pragma unroll
      for (int tj = 0; tj < 4; ++tj) {
        const int n = cbase + 16 * tj;
        const float v = (m < 1023) ? gelu_tanh(acc[ti][tj][j] + bias[tj]) : 0.f;
        H[(long)m * 256 + n] = f2bf(v);
      }
    }
}

DI void cmp2_tile(const Params& p, int tile, char* smem) {
  const int z = tile >> 3, mt = tile & 7;
  const int kind = z >> 3, bg = z & 7;
  const int m0 = mt * 128, n0 = 0;
  const u16* A = (const u16*)(p.ws + OFF_H) + (long)z * 1024 * 256 + (long)m0 * 256;
  f32x4 acc[4][4];
  gemm_main<false>(A, 256, 128, wsW(p) + (kind ? W_C2V : W_C2K), 256, 256, acc, smem);
  EPI_COORDS
  if (kind == 0) {
    u16* Kc = (u16*)(p.ws + OFF_KCMP) + (long)bg * 1024 * 128;
#pragma unroll
    for (int ti = 0; ti < 4; ++ti)
#pragma unroll
      for (int j = 0; j < 4; ++j) {
        const int m = rbase + 16 * ti + j;
#pragma unroll
        for (int tj = 0; tj < 4; ++tj) Kc[(long)m * 128 + cbase + 16 * tj] = f2bf(m < 1023 ? acc[ti][tj][j] : 0.f);
      }
  } else {
    u16* Vc = (u16*)(p.ws + OFF_VCMPT) + (long)bg * 128 * 1024;
#pragma unroll
    for (int ti = 0; ti < 4; ++ti) {
      const int mrow0 = rbase + 16 * ti;
#pragma unroll
      for (int tj = 0; tj < 4; ++tj) {
        const int n = cbase + 16 * tj;
        const float v3 = (mrow0 + 3 < 1023) ? acc[ti][tj][3] : 0.f;
        *(uint2*)(Vc + ((long)(mrow0 >> 6) * 128 + n) * 64 + (mrow0 & 63)) = pack4(acc[ti][tj][0], acc[ti][tj][1], acc[ti][tj][2], v3);
      }
    }
  }
}

DI void nsa_gate_tile(const Params& p, int tile, char* smem) {
  int mt, nt;
  decode_xcd(tile, 16, mt, nt);
  const int m0 = mt * 256, n0 = nt * 128;
  f32x4 acc[8][4];
  gemm_main8<true>((const u16*)(p.ws + OFF_XB2) + (long)m0 * 1024, 1024, wsW(p) + W_NSA + (long)(2176 + n0) * 1024, 1024, 1024, acc, smem);
  EPI_COORDS_S(128)
  const float* ssq = (const float*)(p.ws + OFF_SSQ2);
  u16* O = (u16*)(p.ws + OFF_QN);
#pragma unroll
  for (int hh = 0; hh < 2; ++hh) {
    float r[4];
    uint2 ov[4][4];
#pragma unroll
    for (int t4 = 0; t4 < 4; ++t4) {
      const long m = rrow + 16 * (4 * hh + t4);
      r[t4] = ssq[m];
#pragma unroll
      for (int tj = 0; tj < 4; ++tj) ov[t4][tj] = *(const uint2*)(O + m * 2048 + ccol + 16 * tj);
    }
    __builtin_amdgcn_sched_barrier(0);
#pragma unroll
    for (int t4 = 0; t4 < 4; ++t4) {
      const int ti = 4 * hh + t4;
      const long m = rrow + 16 * ti;
      const float rr = rsqrtf(r[t4] * (1.f / 1024.f) + 1e-6f);
#pragma unroll
      for (int tj = 0; tj < 4; ++tj) {
        const uint2 o = ov[t4][tj];
        const float o0 = __uint_as_float(o.x << 16), o1 = __uint_as_float(o.x & 0xffff0000u);
        const float o2 = __uint_as_float(o.y << 16), o3 = __uint_as_float(o.y & 0xffff0000u);
        const float g0 = acc[ti][tj][0] * rr, g1 = acc[ti][tj][1] * rr, g2 = acc[ti][tj][2] * rr, g3 = acc[ti][tj][3] * rr;
        *(uint2*)(O + m * 2048 + ccol + 16 * tj) = pack4h(g0 * sigmoidf_(g0) * o0, g1 * sigmoidf_(g1) * o1, g2 * sigmoidf_(g2) * o2, g3 * sigmoidf_(g3) * o3);
      }
    }
    __builtin_amdgcn_sched_barrier(0);
  }
}

DI void nsa_out_tile(const Params& p, int tile, char* smem) {
  int mt, nt;
  decode_xcd(tile, 8, mt, nt);
  const int m0 = mt * 256, n0 = nt * 128;
  f32x4 acc[8][4];
  gemm_main8<true>((const u16*)(p.ws + OFF_QN) + (long)m0 * 2048, 2048, wsW(p) + W_NSA_OUT + (long)n0 * 2048, 2048, 2048, acc, smem);
  EPI_COORDS_S(128)
#pragma unroll
  for (int hh = 0; hh < 2; ++hh) {
    float4 hv[4][4];
#pragma unroll
    for (int t4 = 0; t4 < 4; ++t4)
#pragma unroll
      for (int tj = 0; tj < 4; ++tj) hv[t4][tj] = *(const float4*)(p.out + (long)(rrow + 16 * (4 * hh + t4)) * 1024 + ccol + 16 * tj);
    __builtin_amdgcn_sched_barrier(0);
#pragma unroll
    for (int t4 = 0; t4 < 4; ++t4) {
      const int ti = 4 * hh + t4;
      const long m = rrow + 16 * ti;
      float ss = 0.f;
#pragma unroll
      for (int tj = 0; tj < 4; ++tj) {
        float4 h = hv[t4][tj];
        h.x += acc[ti][tj][0]; h.y += acc[ti][tj][1]; h.z += acc[ti][tj][2]; h.w += acc[ti][tj][3];
        *(float4*)(p.out + m * 1024 + ccol + 16 * tj) = h;
        *(uint2*)((u16*)(p.ws + OFF_XB) + m * 1024 + ccol + 16 * tj) = pack4h(h.x, h.y, h.z, h.w);
        ss += h.x * h.x + h.y * h.y + h.z * h.z + h.w * h.w;
      }
      ss = xsum16(xsum32(ss));
      if (g == 0) atomicAdd((float*)(p.ws + OFF_SSQ3) + m, ss);
    }
    __builtin_amdgcn_sched_barrier(0);
  }
}

DI void wave_lds_fence() {
  __builtin_amdgcn_wave_barrier();
  asm volatile("s_waitcnt lgkmcnt(0)" ::: "memory");
  __builtin_amdgcn_wave_barrier();
}

DI bf16x8 pack8_mfma(float a0, float a1, float a2, float a3, float a4, float a5, float a6, float a7) {
  u32 p0, p1, p2, p3;
  asm volatile("v_cvt_pk_bf16_f32 %0, %4, %5\n\tv_cvt_pk_bf16_f32 %1, %6, %7\n\tv_cvt_pk_bf16_f32 %2, %8, %9\n\tv_cvt_pk_bf16_f32 %3, %10, %11\n\ts_nop 1"
               : "=&v"(p0), "=&v"(p1), "=&v"(p2), "=&v"(p3)
               : "v"(a0), "v"(a1), "v"(a2), "v"(a3), "v"(a4), "v"(a5), "v"(a6), "v"(a7));
  return __builtin_bit_cast(bf16x8, make_uint4(p0, p1, p2, p3));
}

constexpr int NSA_IMP_OFF = 32768;
constexpr int NSA_IMP_WAVE = 8 * 260 * 4;
constexpr int NSA_MASK_OFF = NSA_IMP_OFF + 4 * NSA_IMP_WAVE;
constexpr int SMEM_BYTES = NSA_MASK_OFF + 1024;

enum { NSA_SEL = 0, NSA_WIN = 1, NSA_CMP1 = 2, NSA_CMP2 = 3 };

template <int MODE, int u>
DI void nsa_block_compute(const char* stage, u32 m8, int j, const bf16x8 (&qf)[4], f32x4 (&O)[8], float& mrun, float& lrun, int tbase,
                          float invl, float& carry_in, float* imp, int l, int w, int c, int g) {
  const u32 mu = (m8 >> (4 * u)) & 0xfu;
  if (!mu) return;
  const int t = tbase + 8 * w + 4 * u + (c >> 2);
  const bool colok = (mu >> (c >> 2)) & 1u;
  int hi, lo;
  if (MODE == NSA_SEL) { hi = t; lo = -1; }
  else if (MODE == NSA_WIN) { hi = t; lo = t - 512; }
  else { hi = max(0, (t - 15) >> 4) - 1; lo = -1; }
  if (!colok) { hi = -1; lo = 0; }
  f32x4 s[4];
#pragma unroll
  for (int half = 0; half < 2; ++half) {
    const int r0 = 32 * half + 8 * (c >> 2) + (c & 3);
    s[2 * half] = f32x4{0.f, 0.f, 0.f, 0.f};
    s[2 * half + 1] = f32x4{0.f, 0.f, 0.f, 0.f};
    bf16x8 ka[8];
#pragma unroll
    for (int ds = 0; ds < 4; ++ds) {
      ka[2 * ds] = *(const bf16x8*)(stage + (r0 * 16 + ((4 * ds + g) ^ c)) * 16);
      ka[2 * ds + 1] = *(const bf16x8*)(stage + ((r0 + 4) * 16 + ((4 * ds + g) ^ c)) * 16);
    }
#pragma unroll
    for (int ds = 0; ds < 4; ++ds) {
      s[2 * half] = MFMA(ka[2 * ds], qf[ds], s[2 * half]);
      s[2 * half + 1] = MFMA(ka[2 * ds + 1], qf[ds], s[2 * half + 1]);
    }
    __builtin_amdgcn_sched_group_barrier(0x100, 8, 0);
    __builtin_amdgcn_sched_group_barrier(0x008, 8, 0);
    __builtin_amdgcn_sched_barrier(0);
  }
  float v[16];
  bool ok[16];
  const int tmin = tbase + 8 * w + 4 * u, tmax = tmin + 3;
  bool interior;
  if (MODE == NSA_SEL) interior = (j * 64 + 63 <= tmin);
  else if (MODE == NSA_WIN) interior = (j * 64 + 63 <= tmin) && (j * 64 > tmax - 512);
  else interior = (j * 64 + 63 <= max(0, (tmin - 15) >> 4) - 1);
  if (interior) {
#pragma unroll
    for (int q = 0; q < 4; ++q)
#pragma unroll
      for (int jj = 0; jj < 4; ++jj) {
        ok[4 * q + jj] = colok;
        v[4 * q + jj] = s[q][jj];
      }
  } else {
#pragma unroll
    for (int q = 0; q < 4; ++q)
#pragma unroll
      for (int jj = 0; jj < 4; ++jj) {
        const int key = j * 64 + 32 * (q >> 1) + 8 * g + 4 * (q & 1) + jj;
        ok[4 * q + jj] = (key > lo) && (key <= hi);
        v[4 * q + jj] = ok[4 * q + jj] ? s[q][jj] : -1e30f;
      }
  }
  if (MODE == NSA_CMP2) {
#pragma unroll
    for (int i = 0; i < 16; ++i) {
      float pr = ok[i] ? __builtin_amdgcn_exp2f(v[i] - mrun) * invl : 0.f;
      pr += dpp_xor1(pr);
      pr += dpp_xor2(pr);
      v[i] = pr;
    }
#pragma unroll
    for (int half = 0; half < 2; ++half) {
      const float* pr = v + 8 * half;
      const float up = __shfl_up(pr[7], 16);
      const float last = __shfl(pr[7], 48 + c);
      const float cin = (g == 0) ? carry_in : up;
      carry_in = last;
      if ((c & 3) == 0) {
        const int bj = 16 * j + 8 * half + 2 * g;
        float* row = imp + (4 * u + (c >> 2)) * 260;
        row[bj] = 2.f * (pr[0] + pr[1] + pr[2]) + pr[3] + cin;
        row[bj + 1] = 2.f * (pr[4] + pr[5] + pr[6]) + pr[7] + pr[3];
      }
    }
    return;
  }
  float mx = v[0];
#pragma unroll
  for (int i = 1; i < 16; ++i) mx = fmaxf(mx, v[i]);
  if (interior) mx = colok ? mx : -1e30f;
  mx = xmax16(xmax32(mx));
  const float mnew = fmaxf(mrun, mx);
  const float alpha = __builtin_amdgcn_exp2f(mrun - mnew);
  mrun = mnew;
  float ls = 0.f;
  if (interior) {
    const float meff = colok ? mnew : 1e30f;
#pragma unroll
    for (int i = 0; i < 16; ++i) {
      v[i] = __builtin_amdgcn_exp2f(v[i] - meff);
      ls += v[i];
    }
  } else {
#pragma unroll
    for (int i = 0; i < 16; ++i) {
      v[i] = ok[i] ? __builtin_amdgcn_exp2f(v[i] - mnew) : 0.f;
      ls += v[i];
    }
  }
  lrun = lrun * alpha + ls;
  if (__builtin_amdgcn_ballot_w64(alpha != 1.f)) {
#pragma unroll
    for (int d = 0; d < 8; ++d) O[d] *= alpha;
  }
  __builtin_amdgcn_sched_barrier(0);
#pragma unroll
  for (int half = 0; half < 2; ++half) {
    const bf16x8 pb = pack8_mfma(v[8 * half], v[8 * half + 1], v[8 * half + 2], v[8 * half + 3], v[8 * half + 4], v[8 * half + 5],
                                 v[8 * half + 6], v[8 * half + 7]);
    bf16x8 va[8];
#pragma unroll
    for (int d = 0; d < 8; ++d) va[d] = *(const bf16x8*)(stage + 16384 + ((16 * d + c) * 8 + ((4 * half + g) ^ ((c >> 1) & 7))) * 16);
#pragma unroll
    for (int d = 0; d < 8; ++d) O[d] = MFMA(va[d], pb, O[d]);
    __builtin_amdgcn_sched_group_barrier(0x100, 8, 0);
    __builtin_amdgcn_sched_group_barrier(0x008, 8, 0);
    __builtin_amdgcn_sched_barrier(0);
  }
}

DI int next_set256(unsigned long long n0, unsigned long long n1, unsigned long long n2, unsigned long long n3, int from) {
  if (from >= 256) return 256;
  const int wd = from >> 6, sh = from & 63;
  unsigned long long b0 = (wd == 0) ? (n0 >> sh) << sh : 0ull;
  unsigned long long b1 = (wd <= 1) ? ((wd == 1) ? (n1 >> sh) << sh : n1) : 0ull;
  unsigned long long b2 = (wd <= 2) ? ((wd == 2) ? (n2 >> sh) << sh : n2) : 0ull;
  unsigned long long b3 = (wd == 3) ? (n3 >> sh) << sh : n3;
  if (b0) return __builtin_ctzll(b0);
  if (b1) return 64 + __builtin_ctzll(b1);
  if (b2) return 128 + __builtin_ctzll(b2);
  if (b3) return 192 + __builtin_ctzll(b3);
  return 256;
}

template <int MODE>
DI void nsa_block_loop(const u16* Kg, const u16* Vg, int jfirst, int jlast, const u32* selmask, char* stage,
                       const bf16x8 (&qf)[2][4], f32x4 (&O)[2][8], float (&mrun)[2], float (&lrun)[2], int tbase,
                       const float (&invl)[2], float* imp, int) {
  const int tid = my_tid(), l = tid & 63, w = tid >> 6, c = l & 15, g = l >> 4;
  const int krow = tid >> 2, kcq = tid & 3, vrow = tid >> 1, vcq = tid & 1;
  const int khs = (krow & 3) | (((krow >> 3) & 3) << 2);
  const int vhs = (vrow >> 1) & 7;
  constexpr bool HASV = (MODE != NSA_CMP2);
  constexpr bool MASKED = (MODE == NSA_SEL);
  uint4 kr0, kr1, kr2, kr3, vr0, vr1, vr2, vr3;
  float cin0 = 0.f, cin1 = 0.f;
  int j = jfirst;
  unsigned long long nz0 = 0, nz1 = 0, nz2 = 0, nz3 = 0;
  u32 mcur = 0u;
  if (MASKED) {
    nz0 = __builtin_amdgcn_ballot_w64(selmask[l] != 0u);
    nz1 = __builtin_amdgcn_ballot_w64(selmask[64 + l] != 0u);
    nz2 = __builtin_amdgcn_ballot_w64(selmask[128 + l] != 0u);
    nz3 = __builtin_amdgcn_ballot_w64(selmask[192 + l] != 0u);
    j = next_set256(nz0, nz1, nz2, nz3, jfirst);
    if (j <= jlast) mcur = selmask[j];
  }
#define NSA_LOADBLK(jj)                                                    \
  {                                                                        \
    const uint4* ks = (const uint4*)(Kg + (long)(jj) * 8192 + tid * 32);    \
    kr0 = ks[0]; kr1 = ks[1]; kr2 = ks[2]; kr3 = ks[3];                     \
    if (HASV) {                                                            \
      const uint4* vs = (const uint4*)(Vg + (long)(jj) * 8192 + tid * 32);  \
      vr0 = vs[0]; vr1 = vs[1]; vr2 = vs[2]; vr3 = vs[3];                   \
    }                                                                      \
  }
  if (j <= jlast) NSA_LOADBLK(j);
  while (j <= jlast) {
    *(uint4*)(stage + (krow * 16 + ((4 * kcq + 0) ^ khs)) * 16) = kr0;
    *(uint4*)(stage + (krow * 16 + ((4 * kcq + 1) ^ khs)) * 16) = kr1;
    *(uint4*)(stage + (krow * 16 + ((4 * kcq + 2) ^ khs)) * 16) = kr2;
    *(uint4*)(stage + (krow * 16 + ((4 * kcq + 3) ^ khs)) * 16) = kr3;
    if (HASV) {
      *(uint4*)(stage + 16384 + (vrow * 8 + ((4 * vcq + 0) ^ vhs)) * 16) = vr0;
      *(uint4*)(stage + 16384 + (vrow * 8 + ((4 * vcq + 1) ^ vhs)) * 16) = vr1;
      *(uint4*)(stage + 16384 + (vrow * 8 + ((4 * vcq + 2) ^ vhs)) * 16) = vr2;
      *(uint4*)(stage + 16384 + (vrow * 8 + ((4 * vcq + 3) ^ vhs)) * 16) = vr3;
    }
    __syncthreads();
    int jn = j + 1;
    u32 mnext = 0u;
    if (MASKED) {
      jn = next_set256(nz0, nz1, nz2, nz3, j + 1);
      mnext = selmask[min(jn, 255)];
    }
    NSA_LOADBLK(jn <= jlast ? jn : j);
    u32 m8 = 0xffu;
    if (MASKED) m8 = (__builtin_amdgcn_readfirstlane(mcur) >> (8 * w)) & 0xffu;
    nsa_block_compute<MODE, 0>(stage, m8, j, qf[0], O[0], mrun[0], lrun[0], tbase, invl[0], cin0, imp, l, w, c, g);
    nsa_block_compute<MODE, 1>(stage, m8, j, qf[1], O[1], mrun[1], lrun[1], tbase, invl[1], cin1, imp, l, w, c, g);
    __syncthreads();
    j = jn;
    mcur = mnext;
  }
#undef NSA_LOADBLK
  if (MODE == NSA_CMP2) {
    if (jlast >= jfirst && g == 0 && (c & 3) == 0) {
      imp[(c >> 2) * 260 + 16 * (jlast + 1)] = cin0;
      imp[(4 + (c >> 2)) * 260 + 16 * (jlast + 1)] = cin1;
    }
  }
}

#define NSA_RECOORD                                                                                      \
  const int tid_ = my_tid(), l_ = tid_ & 63, w_ = tid_ >> 6, c_ = l_ & 15, g_ = l_ >> 4;                   \
  const int head_ = grp * 4 + (c_ & 3);                                                                  \
  const int mrow_ = b * T + tbase + 8 * w_ + (c_ >> 2);                                                  \
  f32x4* scr_ = (f32x4*)(p.ws + OFF_KV) + (((long)blockIdx.x * 4 + w_) * 64 + l_) * 16;                  \
  (void)g_; (void)head_; (void)mrow_; (void)scr_;
DI void nsa_item(const Params& p, int item, char* smem) {
  const int tid = my_tid(), l = tid & 63, w = tid >> 6, c = l & 15, g = l >> 4;
  int bg, tile;
  if (gridDim.x == 512) {
    const int k = item >> 9, q = (item & 511) >> 3;
    const int base = q + 64 * (k >> 1);
    bg = item & 7;
    tile = (k & 1) ? base : 511 - base;
  } else {
    bg = item >> 9;
    const int s512 = item & 511;
    tile = (bg & 1) ? 511 - s512 : s512;
  }
  const int b = bg >> 2, grp = bg & 3;
  const int tbase = tile * 32;
  const int cur = tbase >> 6;
  const int head = grp * 4 + (c & 3);
  float* imp = (float*)(smem + NSA_IMP_OFF + w * NSA_IMP_WAVE);
  u32* selmask = (u32*)(smem + NSA_MASK_OFF);
  u16* Qn = (u16*)(p.ws + OFF_QN);
  const float* gates = (const float*)(p.ws + OFF_GATES);

  selmask[tid] = 0u;
  for (int i = l; i < 8 * 260; i += 64) imp[i] = 0.f;
  __syncthreads();

  bf16x8 qf[2][4];
  const int mrow0 = b * T + tbase + 8 * w + (c >> 2);
#pragma unroll
  for (int u = 0; u < 2; ++u) {
#pragma unroll
    for (int ds = 0; ds < 4; ++ds) qf[u][ds] = *(const bf16x8*)(Qn + (long)(mrow0 + 4 * u) * 2048 + head * 128 + 32 * ds + 8 * g);
  }
  f32x4 O[2][8];
  float mrun[2], lrun[2], invl[2];
#pragma unroll
  for (int u = 0; u < 2; ++u) {
    mrun[u] = -1e30f;
    lrun[u] = 0.f;
    invl[u] = 0.f;
#pragma unroll
    for (int d = 0; d < 8; ++d) O[u][d] = f32x4{0.f, 0.f, 0.f, 0.f};
  }
  const int ncvmax = max(0, (tbase + 31 - 15) >> 4);
  const int nbc = (ncvmax + 63) >> 6;
  const u16* Kc = (const u16*)(p.ws + OFF_KCMP) + (long)bg * 1024 * 128;
  const u16* Vc = (const u16*)(p.ws + OFF_VCMPT) + (long)bg * 128 * 1024;
  nsa_block_loop<NSA_CMP1>(Kc, Vc, 0, nbc - 1, selmask, smem, qf, O, mrun, lrun, tbase, invl, imp, tid);
  {
    NSA_RECOORD
#pragma unroll
    for (int u = 0; u < 2; ++u) {
      const float ltot = xsum16(xsum32(lrun[u]));
      invl[u] = ltot > 0.f ? 1.f / ltot : 0.f;
      const float gc = gates[(mrow_ + 4 * u) * 48 + head_ * 3 + 0] * invl[u];
#pragma unroll
      for (int d = 0; d < 8; ++d) {
        scr_[u * 8 + d] = O[u][d] * gc;
        O[u][d] = f32x4{0.f, 0.f, 0.f, 0.f};
      }
    }
  }
  nsa_block_loop<NSA_CMP2>(Kc, Vc, 0, nbc - 1, selmask, smem, qf, O, mrun, lrun, tbase, invl, imp, tid);
  wave_lds_fence();
  for (int tk = 0; tk < 8; ++tk) {
    const int tt = tbase + 8 * w + tk;
    u32 key[4];
#pragma unroll
    for (int e = 0; e < 4; ++e) {
      const int j = l + 64 * e;
      const float v = imp[tk * 260 + j];
      const bool forced = (j == 0) || (j == cur) || (j == cur - 1);
      const float sc = forced ? 1e30f : fmaxf(v, 0.f);
      key[e] = (j <= cur) ? ((__float_as_uint(sc) & ~0x1ffu) | ((u32)(255 - j) << 1) | 1u) : 0u;
    }
    u32 ans = 0u;
    for (int bit = 31; bit >= 0; --bit) {
      const u32 cand = ans | (1u << bit);
      int cnt = 0;
#pragma unroll
      for (int e = 0; e < 4; ++e) cnt += __builtin_popcountll(__builtin_amdgcn_ballot_w64(key[e] >= cand));
      if (cnt >= 16) ans = cand;
    }
#pragma unroll
    for (int e = 0; e < 4; ++e)
      if (key[e] != 0u && key[e] >= ans) atomicOr(&selmask[l + 64 * e], 1u << (8 * w + tk));
  }
  __syncthreads();

#pragma unroll
  for (int u = 0; u < 2; ++u) {
    mrun[u] = -1e30f;
    lrun[u] = 0.f;
  }
  nsa_block_loop<NSA_SEL>(kvpart(p, 2) + (long)bg * T * 128, kvpart(p, 3) + (long)bg * 256 * 128 * 64, 0, cur, selmask, smem, qf, O, mrun,
                          lrun, tbase, invl, imp, tid);
  {
    NSA_RECOORD
#pragma unroll
    for (int u = 0; u < 2; ++u) {
      const float ltot = xsum16(xsum32(lrun[u]));
      const float gs = gates[(mrow_ + 4 * u) * 48 + head_ * 3 + 1] / ltot;
#pragma unroll
      for (int d = 0; d < 8; ++d) {
        f32x4 a = scr_[u * 8 + d];
        a += O[u][d] * gs;
        scr_[u * 8 + d] = a;
        O[u][d] = f32x4{0.f, 0.f, 0.f, 0.f};
      }
      mrun[u] = -1e30f;
      lrun[u] = 0.f;
    }
  }
  nsa_block_loop<NSA_WIN>(kvpart(p, 4) + (long)bg * T * 128, kvpart(p, 5) + (long)bg * 256 * 128 * 64, max(0, tbase - 511) >> 6, cur,
                          selmask, smem, qf, O, mrun, lrun, tbase, invl, imp, tid);
  {
    NSA_RECOORD
#pragma unroll
    for (int u = 0; u < 2; ++u) {
      const float ltot = xsum16(xsum32(lrun[u]));
      const float gw = gates[(mrow_ + 4 * u) * 48 + head_ * 3 + 2] / ltot;
#pragma unroll
      for (int d = 0; d < 8; ++d) {
        f32x4 a = scr_[u * 8 + d];
        a += O[u][d] * gw;
        *(uint2*)(Qn + (long)(mrow_ + 4 * u) * 2048 + head_ * 128 + 16 * d + 4 * g_) = pack4(a[0], a[1], a[2], a[3]);
      }
    }
  }
}
#undef NSA_RECOORD

#define XB_TMO      128
#define XB_XCNT(j)  (256  + 64 * (j))
#define XB_XSUB(j)  (1280 + 64 * (j))
#define XB_XGEN(j)  (2304 + 64 * (j))
#define XB_TOP      3328
#define XB_TOPGEN   3392
#define XCD_BAR_WORDS 3456
#define XB_SPIN_CAP (1u << 18)
#define LAS __attribute__((address_space(3)))

__device__ __forceinline__ unsigned xb_ld(unsigned* p)              { return __hip_atomic_load(p, __ATOMIC_RELAXED, __HIP_MEMORY_SCOPE_AGENT); }
__device__ __forceinline__ unsigned xb_add(unsigned* p, unsigned v) { return __hip_atomic_fetch_add(p, v, __ATOMIC_RELAXED, __HIP_MEMORY_SCOPE_AGENT); }
__device__ __forceinline__ unsigned xb_xcc_id() { return (unsigned)__builtin_amdgcn_s_getreg((3 << 11) | 20) & 0xFu; }
#define XB_SPIN(cond, bar) do { unsigned _sp = 0; while (cond) { __builtin_amdgcn_s_sleep(1); \
    if ((++_sp & 255u) == 0u) { if (xb_ld(&(bar)[XB_TMO])) break; if (_sp > XB_SPIN_CAP) { atomicAdd(&(bar)[XB_TMO], 1u); break; } } } } while (0)

struct XcdBarrier {
    unsigned* bar; unsigned x;
    volatile LAS unsigned* st;
};

__device__ __forceinline__ XcdBarrier xcd_barrier_post(unsigned* bar, volatile LAS unsigned* st) {
    XcdBarrier b; b.bar = bar; b.x = xb_xcc_id(); b.st = st;
    if (threadIdx.x == 0) (void)xb_add(&bar[XB_XCNT(b.x)], 1u);
    return b;
}
__device__ __forceinline__ void xcd_barrier_complete(unsigned* bar, unsigned x, unsigned& nloc, unsigned& nx) {
    const unsigned G = gridDim.x * gridDim.y * gridDim.z;
    unsigned sum, cnt, mine, sp = 0u;
    for (;;) {
        sum = 0u; cnt = 0u; mine = 0u;
#pragma unroll
        for (unsigned j = 0; j < 16; ++j) { const unsigned c = xb_ld(&bar[XB_XCNT(j)]); sum += c; cnt += (c > 0u) ? 1u : 0u; mine = (j == x) ? c : mine; }
        if (sum == G) break;
        __builtin_amdgcn_s_sleep(1);
        if ((++sp & 255u) == 0u) { if (xb_ld(&bar[XB_TMO])) break; if (sp > XB_SPIN_CAP) { atomicAdd(&bar[XB_TMO], 1u); break; } }
    }
    nloc = mine > 0u ? mine : 1u; nx = cnt > 0u ? cnt : 1u;
}

__device__ __forceinline__ void xcd_barrier(const XcdBarrier& b) {
    asm volatile("s_waitcnt vmcnt(0)" ::: "memory");
    __syncthreads();
    if (threadIdx.x == 0) {
        unsigned* bar = b.bar;
        __builtin_amdgcn_s_waitcnt(0);
        unsigned nloc = b.st[0], nx = b.st[1];
        if (nloc == 0u) { xcd_barrier_complete(bar, b.x, nloc, nx); b.st[0] = nloc; b.st[1] = nx; }
        const unsigned old = xb_add(&bar[XB_XSUB(b.x)], 1u);
        const unsigned gen = old / nloc;
        if (old + 1u == (gen + 1u) * nloc) {
            __builtin_amdgcn_fence(__ATOMIC_RELEASE, "agent");
            asm volatile("s_waitcnt vmcnt(0)" ::: "memory");
            const unsigned og = xb_add(&bar[XB_TOP], 1u);
            const unsigned tg = og / nx;
            if (og + 1u == (tg + 1u) * nx) xb_add(&bar[XB_TOPGEN], 1u);
            else XB_SPIN(xb_ld(&bar[XB_TOPGEN]) == tg, bar);
            __builtin_amdgcn_fence(__ATOMIC_ACQUIRE, "agent");
            xb_add(&bar[XB_XGEN(b.x)], 1u);
            asm volatile("s_waitcnt vmcnt(0)" ::: "memory");
        } else {
            XB_SPIN(xb_ld(&bar[XB_XGEN(b.x)]) == gen, bar);
            __builtin_amdgcn_fence(__ATOMIC_ACQUIRE, "agent");
            asm volatile("s_waitcnt vmcnt(0)" ::: "memory");
        }
    }
    __syncthreads();
}


constexpr long OFF_XBAR = OFF_BIAS + 512 * 1024;

constexpr int NPHASE = 19;
DI void run_phase(const Params& p, int ph, char* smem) {
  const int bid = blockIdx.x, nb = gridDim.x;
#ifdef PH_ONLY
  if (ph != PH_ONLY) return;
  ph = PH_ONLY;
#endif
  switch (ph) {
    case 0: {
      for (int i = bid; i < CONV_TILES; i += nb) conv_tile(p, i, smem);
      {
        u32* z = (u32*)(wsW(p) + W_NSA + 2096l * 1024);
        for (int i = bid * 256 + my_tid(); i < 80 * 512; i += nb * 256) z[i] = 0u;
      }
      for (int i = bid; i < 64; i += nb) bias_item(p, i, smem);
      {
        float* z = (float*)(p.ws + OFF_SSQ1);
        for (int i = bid * 256 + my_tid(); i < 3 * 32768; i += nb * 256) z[i] = 0.f;
      }
      for (int i = bid; i < M / 4; i += nb) rownorm_item(p, p.x, i);
    } break;
    case 1: for (int i = bid; i < 128 * 32; i += nb) ret_qkv_tile(p, i, smem); break;
    case 2: for (int i = bid; i < 1024; i += nb) ret_p_tile(p, i, smem); break;
    case 3: for (int i = bid; i < 256; i += nb) ret_scan_item(p, i, smem); break;
    case 4: for (int i = bid; i < M / 4; i += nb) stats_item(p, i); break;
    case 5: for (int i = bid; i < 128 * 16; i += nb) ret_gate_tile(p, i, smem); break;
    case 6: for (int i = bid; i < 128 * 8; i += nb) ret_out_tile(p, i, smem); break;
    case 7: for (int i = bid; i < M / 4; i += nb) rownorm_item(p, p.out, i); break;
    case 8: for (int i = bid; i < 256 * 8; i += nb) ple_tile(p, 0, i, smem); break;
    case 9: for (int i = bid; i < M / 4; i += nb) rownorm_item(p, p.out, i); break;
    case 10: for (int i = bid; i < 128 * 24; i += nb) kv_tile(p, i, smem); break;
    case 11: {
      const int half = nb >> 1;
      if (bid < half) {
        for (int i = bid; i < 256; i += half) cmp1_tile(p, i, smem);
      } else {
        for (int i = bid - half; i < 128 * 17; i += nb - half) nsaq_tile(p, i, smem);
      }
    } break;
    case 12: for (int i = bid; i < 128; i += nb) cmp2_tile(p, i, smem); break;
    case 13: for (int i = bid; i < 8 * 512; i += nb) nsa_item(p, i, smem); break;
    case 14: for (int i = bid; i < 128 * 16; i += nb) nsa_gate_tile(p, i, smem); break;
    case 15: for (int i = bid; i < 128 * 8; i += nb) nsa_out_tile(p, i, smem); break;
    case 16: for (int i = bid; i < M / 4; i += nb) rownorm_item(p, p.out, i); break;
    case 17: for (int i = bid; i < 256 * 8; i += nb) ple_tile(p, 1, i, smem); break;
    default: for (int i = bid; i < M / 4; i += nb) finalnorm_item(p, i); break;
  }
}

#if !MEGA
__global__ void __launch_bounds__(256) k_phase(Params p, int ph) {
  __shared__ __attribute__((aligned(16))) char smem[SMEM_BYTES];
  run_phase(p, ph, smem);
}

#else
__global__ void __launch_bounds__(256, 2) k_mega(Params p) {
  __shared__ __attribute__((aligned(16))) char smem[SMEM_BYTES];
  cg::grid_group grid = cg::this_grid();
  __shared__ uint4 xb_words;
  if (threadIdx.x == 0) xb_words = make_uint4(0u, 0u, 0u, 0u);
  __syncthreads();
  XcdBarrier xb = xcd_barrier_post((unsigned*)(p.ws + OFF_XBAR), (volatile LAS unsigned*)&xb_words);
  if (p.ws == nullptr) grid.sync();
  run_phase(p, 0, smem);
  xcd_barrier(xb);
#define PH(n) run_phase(p, n, smem); xcd_barrier(xb);
  PH(1) PH(2) PH(3) PH(4) PH(5) PH(6) PH(8) PH(10) PH(11) PH(12) PH(13) PH(14) PH(15) PH(17)
#undef PH
  run_phase(p, 18, smem);
}
#endif

extern "C" void kernel_launch(void* const* d_in, const int* in_sizes, int n_in, void* d_out, int out_size, void* d_ws,
                              size_t ws_size, hipStream_t stream) {
  if (ws_size < (size_t)WS_NEED) {
    fprintf(stderr, "workspace too small: %zu\n", ws_size);
    return;
  }
  Params p{};
  const float** f = (const float**)&p;
  for (int i = 0; i < 21; ++i) f[i] = (const float*)d_in[i];
  p.out = (float*)d_out;
  p.ws = (char*)d_ws;
  static int grid_blocks = 0;
  if (!grid_blocks) {
    int dev = 0, cus = 0, per_cu = 0;
    (void)hipGetDevice(&dev);
    (void)hipDeviceGetAttribute(&cus, hipDeviceAttributeMultiprocessorCount, dev);
#if MEGA
    (void)hipOccupancyMaxActiveBlocksPerMultiprocessor(&per_cu, k_mega, 256, 0);
#else
    (void)hipOccupancyMaxActiveBlocksPerMultiprocessor(&per_cu, k_phase, 256, 0);
#endif
    if (per_cu < 1) per_cu = 1;
    grid_blocks = cus * per_cu;
    if (grid_blocks > 1024) grid_blocks = 1024;
  }
#if MEGA
  (void)hipMemsetAsync((char*)d_ws + OFF_XBAR, 0, XCD_BAR_WORDS * sizeof(unsigned), stream);
  void* args[] = {&p};
  hipError_t e = hipLaunchCooperativeKernel((void*)k_mega, dim3(grid_blocks), dim3(256), args, 0, stream);
  if (e != hipSuccess) fprintf(stderr, "cooperative launch failed: %s (grid %d)\n", hipGetErrorString(e), grid_blocks);
#else
  for (int ph = 0; ph < NPHASE; ++ph) k_phase<<<grid_blocks, 256, 0, stream>>>(p, ph);
#endif
}
```

```cpp
#include <hip/hip_runtime.h>
#include <hip/hip_cooperative_groups.h>
#include <cstdio>
namespace cg = cooperative_groups;

#ifndef MEGA
#define MEGA 1
#endif

typedef unsigned short u16;
typedef unsigned int u32;
using bf16x8 = __attribute__((ext_vector_type(8))) short;
using f32x4 = __attribute__((ext_vector_type(4))) float;
#define DI __device__ __forceinline__
#define MFMA(a, b, c) __builtin_amdgcn_mfma_f32_16x16x32_bf16((a), (b), (c), 0, 0, 0)

constexpr int T = 16384, M = 32768;
constexpr long MiB = 1l << 20;
constexpr long W_RET_IN = 0;
constexpr long W_RET_OUT = W_RET_IN + 6144l * 1024;
constexpr long W_KV = W_RET_OUT + 1024l * 2048;
constexpr long W_C1K = W_KV + 3072l * 1024;
constexpr long W_C1V = W_C1K + 256l * 4096;
constexpr long W_C2K = W_C1V + 256l * 4096;
constexpr long W_C2V = W_C2K + 128l * 256;
constexpr long W_NSA = W_C2V + 128l * 256;
constexpr long W_NSA_OUT = W_NSA + 4224l * 1024;
constexpr long W_PG = W_NSA_OUT + 1024l * 2048;
constexpr long W_PE = W_PG + 2l * 1024 * 1024;
constexpr long W_END = W_PE + 2l * 1024 * 256;
static_assert(W_END * 2 < 47 * MiB, "weights region");
constexpr long OFF_BIAS = 47 * MiB;
constexpr long OFF_XB = 48 * MiB, OFF_RS = 112 * MiB, OFF_STATS = 113 * MiB;
constexpr long OFF_Q = 114 * MiB, OFF_K = 178 * MiB, OFF_KTD = 242 * MiB, OFF_VT = 306 * MiB, OFF_P = 434 * MiB;
constexpr long OFF_A2 = OFF_Q;
constexpr long OFF_KV = 114 * MiB;
constexpr long OFF_QN = 306 * MiB;
constexpr long OFF_GATES = 48 * MiB, OFF_KCMP = 54 * MiB, OFF_VCMPT = 56 * MiB, OFF_H = 58 * MiB;
constexpr long OFF_XB2 = 434 * MiB;
constexpr long OFF_SSQ1 = OFF_RS + 128 * 1024, OFF_SSQ2 = OFF_RS + 256 * 1024, OFF_SSQ3 = OFF_RS + 384 * 1024;
constexpr long WS_NEED = 498 * MiB;

struct Params {
  const float *x, *p, *ret_norm, *ret_w_in, *ret_gn, *ret_w_out, *kv_norm, *kv_w, *cmp_pe_k, *cmp_w1_k, *cmp_w2_k,
      *cmp_pe_v, *cmp_w1_v, *cmp_w2_v, *nsa_norm, *nsa_w_in, *nsa_w_out, *ple_norm, *ple_w_gate, *ple_w_emb, *final_norm;
  float* out;
  char* ws;
};

DI int my_tid() {
  int t = threadIdx.x;
  asm volatile("" : "+v"(t));
  return t;
}
DI float xmax32(float x) {
  auto r = __builtin_amdgcn_permlane32_swap(__float_as_uint(x), __float_as_uint(x), false, false);
  return fmaxf(__uint_as_float(r[0]), __uint_as_float(r[1]));
}
DI float xmax16(float x) {
  auto r = __builtin_amdgcn_permlane16_swap(__float_as_uint(x), __float_as_uint(x), false, false);
  return fmaxf(__uint_as_float(r[0]), __uint_as_float(r[1]));
}
DI float xsum32(float x) {
  auto r = __builtin_amdgcn_permlane32_swap(__float_as_uint(x), __float_as_uint(x), false, false);
  return __uint_as_float(r[0]) + __uint_as_float(r[1]);
}
DI float xsum16(float x) {
  auto r = __builtin_amdgcn_permlane16_swap(__float_as_uint(x), __float_as_uint(x), false, false);
  return __uint_as_float(r[0]) + __uint_as_float(r[1]);
}
DI float dpp_xor1(float x) { return __int_as_float(__builtin_amdgcn_update_dpp(0, __float_as_int(x), 0xB1, 0xF, 0xF, true)); }
DI float dpp_xor2(float x) { return __int_as_float(__builtin_amdgcn_update_dpp(0, __float_as_int(x), 0x4E, 0xF, 0xF, true)); }

DI void lds_barrier() { asm volatile("s_waitcnt lgkmcnt(0)\n\ts_barrier" ::: "memory"); }
DI float4 ld_nt4(const float* p) {
  const f32x4 v = __builtin_nontemporal_load((const f32x4*)p);
  return make_float4(v[0], v[1], v[2], v[3]);
}
DI void st_nt4(float* p, float4 v) { __builtin_nontemporal_store(f32x4{v.x, v.y, v.z, v.w}, (f32x4*)p); }

DI u16 f2bf(float x) {
  u32 u = __float_as_uint(x);
  u += 0x7fffu + ((u >> 16) & 1u);
  return (u16)(u >> 16);
}
DI float bf2f(u16 h) { return __uint_as_float(((u32)h) << 16); }
DI u32 pack2(float a, float b) { return (u32)f2bf(a) | ((u32)f2bf(b) << 16); }
DI u32 pack2h(float a, float b) {
  u32 r;
  asm("v_cvt_pk_bf16_f32 %0, %1, %2" : "=v"(r) : "v"(a), "v"(b));
  return r;
}
DI uint2 pack4h(float a, float b, float c, float d) { return make_uint2(pack2h(a, b), pack2h(c, d)); }
DI uint2 pack4(float a, float b, float c, float d) { return make_uint2(pack2(a, b), pack2(c, d)); }
DI float sigmoidf_(float x) { return __builtin_amdgcn_rcpf(1.f + __expf(-x)); }
DI u16* wsW(const Params& p) { return (u16*)p.ws; }

struct ConvJob {
  const float* src;
  const float* gain;
  u16* dst;
  int K, N, mode, ntn;
};
DI ConvJob get_job(const Params& p, int j) {
  ConvJob c;
  u16* W = wsW(p);
  c.gain = nullptr;
  c.mode = 0;
  switch (j) {
    case 0: c.src = p.ret_w_in; c.gain = p.ret_norm; c.dst = W + W_RET_IN; c.K = 1024; c.N = 6144; c.mode = 1; break;
    case 1: c.src = p.ret_w_out; c.dst = W + W_RET_OUT; c.K = 2048; c.N = 1024; break;
    case 2: c.src = p.kv_w; c.gain = p.kv_norm; c.dst = W + W_KV; c.K = 1024; c.N = 3072; break;
    case 3: c.src = p.cmp_w1_k; c.dst = W + W_C1K; c.K = 4096; c.N = 256; break;
    case 4: c.src = p.cmp_w1_v; c.dst = W + W_C1V; c.K = 4096; c.N = 256; break;
    case 5: c.src = p.cmp_w2_k; c.dst = W + W_C2K; c.K = 256; c.N = 128; break;
    case 6: c.src = p.cmp_w2_v; c.dst = W + W_C2V; c.K = 256; c.N = 128; break;
    case 7: c.src = p.nsa_w_in; c.gain = p.nsa_norm; c.dst = W + W_NSA; c.K = 1024; c.N = 4144; c.mode = 2; break;
    case 8: c.src = p.nsa_w_out; c.dst = W + W_NSA_OUT; c.K = 2048; c.N = 1024; break;
    case 9: c.src = p.ple_w_gate; c.gain = p.ple_norm; c.dst = W + W_PG; c.K = 1024; c.N = 1024; break;
    case 10: c.src = p.ple_w_gate + 1024l * 1024; c.gain = p.ple_norm + 1024; c.dst = W + W_PG + 1024l * 1024; c.K = 1024; c.N = 1024; break;
    case 11: c.src = p.ple_w_emb; c.dst = W + W_PE; c.K = 256; c.N = 1024; break;
    default: c.src = p.ple_w_emb + 256l * 1024; c.dst = W + W_PE + 1024l * 256; c.K = 256; c.N = 1024; break;
  }
  c.ntn = (c.N + 63) >> 6;
  return c;
}
DI int conv_ntiles(int j) {
  switch (j) {
    case 0: return 16 * 96;
    case 1: return 32 * 16;
    case 2: return 16 * 48;
    case 3: case 4: return 64 * 4;
    case 5: case 6: return 4 * 2;
    case 7: return 16 * 65;
    case 8: return 32 * 16;
    case 9: case 10: return 16 * 16;
    default: return 4 * 16;
  }
}
constexpr int CONV_TILES = 1536 + 512 + 768 + 512 + 16 + 1040 + 512 + 512 + 128;

DI int conv_dst_row(int mode, int n) {
  if (mode == 1) {
    if (n >= 2048) return n;
    int part = n >> 10, nn = n & 1023, head = nn >> 8, d = nn & 255, s = d >> 7, i = d & 127;
    return part * 1024 + head * 256 + 32 * (i >> 4) + 16 * s + (i & 15);
  } else if (mode == 2) {
    if (n < 2048) return n;
    if (n < 4096) return 2176 + (n - 2048);
    return 2048 + (n - 4096);
  }
  return n;
}

DI void conv_tile(const Params& p, int tile, char* smem) {
  int j = 0;
  for (; j < 12; ++j) {
    int nt = conv_ntiles(j);
    if (tile < nt) break;
    tile -= nt;
  }
  ConvJob cj = get_job(p, j);
  const int tk = tile / cj.ntn, tn = tile % cj.ntn;
  const int k0 = tk * 64, n0 = tn * 64;
  float* tl = (float*)smem;
  const int tid = my_tid();
  {
    const int r = tid >> 4, c4 = tid & 15;
    const int n = n0 + 4 * c4;
#pragma unroll
    for (int i = 0; i < 4; ++i) {
      const int k = r + 16 * i;
      float4 v = make_float4(0.f, 0.f, 0.f, 0.f);
      if (n < cj.N) v = ld_nt4(cj.src + (long)(k0 + k) * cj.N + n);
      float* d = tl + k * 65 + 4 * c4;
      d[0] = v.x; d[1] = v.y; d[2] = v.z; d[3] = v.w;
    }
  }
  __syncthreads();
  {
    const int nn = tid >> 2, kq = tid & 3;
    const int n = n0 + nn;
    if (n < cj.N) {
      const int row = conv_dst_row(cj.mode, n);
      u32 o[8];
#pragma unroll
      for (int i = 0; i < 8; ++i) {
        const int k = 16 * kq + 2 * i;
        float a = tl[k * 65 + nn], b = tl[(k + 1) * 65 + nn];
        if (cj.gain) { a *= cj.gain[k0 + k]; b *= cj.gain[k0 + k + 1]; }
        o[i] = pack2(a, b);
      }
      uint4* dst = (uint4*)(cj.dst + (long)row * cj.K + k0 + 16 * kq);
      dst[0] = make_uint4(o[0], o[1], o[2], o[3]);
      dst[1] = make_uint4(o[4], o[5], o[6], o[7]);
    }
  }
  __syncthreads();
}

DI void bias_item(const Params& p, int item, char* smem) {
  const int kind = item >> 5, kq = item & 31;
  const float* pe = kind ? p.cmp_pe_v : p.cmp_pe_k;
  const float* w1 = kind ? p.cmp_w1_v : p.cmp_w1_k;
  const int n = my_tid();
  float s0 = 0.f, s1 = 0.f, s2 = 0.f, s3 = 0.f;
#pragma unroll 8
  for (int k = kq * 128; k < (kq + 1) * 128; k += 4) {
    s0 += pe[k] * w1[(long)k * 256 + n];
    s1 += pe[k + 1] * w1[(long)(k + 1) * 256 + n];
    s2 += pe[k + 2] * w1[(long)(k + 2) * 256 + n];
    s3 += pe[k + 3] * w1[(long)(k + 3) * 256 + n];
  }
  ((float*)(p.ws + OFF_BIAS))[(kind * 32 + kq) * 256 + n] = (s0 + s1) + (s2 + s3);
}

DI void rownorm_item(const Params& p, const float* h, int item) {
  const int l = my_tid() & 63, w = my_tid() >> 6;
  const int row = item * 4 + w;
  const float* src = h + (long)row * 1024;
  u16* xb = (u16*)(p.ws + OFF_XB) + (long)row * 1024;
  float ss = 0.f;
#pragma unroll
  for (int i = 0; i < 4; ++i) {
    float4 v = *(const float4*)(src + 256 * i + 4 * l);
    ss += v.x * v.x + v.y * v.y + v.z * v.z + v.w * v.w;
    *(uint2*)(xb + 256 * i + 4 * l) = pack4(v.x, v.y, v.z, v.w);
  }
#pragma unroll
  for (int o = 32; o >= 1; o >>= 1) ss += __shfl_xor(ss, o);
  if (l == 0) ((float*)(p.ws + OFF_RS))[row] = rsqrtf(ss * (1.f / 1024.f) + 1e-6f);
}

DI void finalnorm_item(const Params& p, int item) {
  const int l = my_tid() & 63, w = my_tid() >> 6;
  const int row = item * 4 + w;
  float* src = p.out + (long)row * 1024;
  float4 v[4];
  float ss = 0.f;
#pragma unroll
  for (int i = 0; i < 4; ++i) {
    v[i] = ld_nt4(src + 256 * i + 4 * l);
    ss += v[i].x * v[i].x + v[i].y * v[i].y + v[i].z * v[i].z + v[i].w * v[i].w;
  }
#pragma unroll
  for (int o = 32; o >= 1; o >>= 1) ss += __shfl_xor(ss, o);
  const float rs = rsqrtf(ss * (1.f / 1024.f) + 1e-6f);
#pragma unroll
  for (int i = 0; i < 4; ++i) {
    float4 gg = *(const float4*)(p.final_norm + 256 * i + 4 * l);
    float4 o = make_float4(v[i].x * rs * gg.x, v[i].y * rs * gg.y, v[i].z * rs * gg.z, v[i].w * rs * gg.w);
    st_nt4(src + 256 * i + 4 * l, o);
  }
}

DI void stats_item(const Params& p, int item) {
  const int l = my_tid() & 63, w = my_tid() >> 6;
  const int row = item * 4 + w;
  const u16* o = (const u16*)p.out + (long)row * 2048 + 32 * l;
  float v[32];
#pragma unroll
  for (int i = 0; i < 4; ++i) {
    uint4 q = *(const uint4*)(o + 8 * i);
    u32 u[4] = {q.x, q.y, q.z, q.w};
#pragma unroll
    for (int e = 0; e < 4; ++e) {
      v[8 * i + 2 * e] = __uint_as_float(u[e] << 16);
      v[8 * i + 2 * e + 1] = __uint_as_float(u[e] & 0xffff0000u);
    }
  }
  float s = 0.f;
#pragma unroll
  for (int i = 0; i < 32; ++i) s += v[i];
#pragma unroll
  for (int o2 = 8; o2 >= 1; o2 >>= 1) s += __shfl_xor(s, o2);
  const float mu = s * (1.f / 512.f);
  float q2 = 0.f;
#pragma unroll
  for (int i = 0; i < 32; ++i) { float d = v[i] - mu; q2 += d * d; }
#pragma unroll
  for (int o2 = 8; o2 >= 1; o2 >>= 1) q2 += __shfl_xor(q2, o2);
  if ((l & 15) == 0) {
    float* st = (float*)(p.ws + OFF_STATS) + ((long)row * 4 + (l >> 4)) * 2;
    st[0] = mu;
    st[1] = rsqrtf(q2 * (1.f / 512.f) + 1e-6f);
  }
}

template <bool AF32, bool SWAP = false>
DI void gemm_main(const void* Abase, long lda, int a_valid, const u16* Bt, long ldb, int K, f32x4 (&acc)[4][4], char* smem) {
  const int tid = my_tid(), l = tid & 63, w = tid >> 6, c = l & 15, g = l >> 4;
  const int wr = w >> 1, wc = w & 1;
  const int lr = tid >> 2, lc = tid & 3;
  u16* As = (u16*)smem;
  u16* Bs = As + 2 * 128 * 32;
  const int wsw = (lc ^ ((0 - (lr >> 2)) & 3)) * 8;
  const int rsw = (g ^ ((0 - (c >> 2)) & 3)) * 8;
  const int ar0 = min(lr, a_valid - 1), ar1 = min(lr + 64, a_valid - 1);
  const u16* bp0 = Bt + (long)lr * ldb + lc * 8;
  const u16* bp1 = Bt + (long)(lr + 64) * ldb + lc * 8;
  uint4 ra0, ra1, rb0, rb1;
#define GEMM_LOAD(k0)                                                                  \
  {                                                                                    \
    if (AF32) {                                                                        \
      const float* a0 = (const float*)Abase + (long)ar0 * lda + (k0) + lc * 8;         \
      const float* a1 = (const float*)Abase + (long)ar1 * lda + (k0) + lc * 8;         \
      float4 x0 = ld_nt4(a0), x1 = ld_nt4(a0 + 4);                                     \
      float4 y0 = ld_nt4(a1), y1 = ld_nt4(a1 + 4);                                     \
      ra0 = make_uint4(pack2(x0.x, x0.y), pack2(x0.z, x0.w), pack2(x1.x, x1.y), pack2(x1.z, x1.w)); \
      ra1 = make_uint4(pack2(y0.x, y0.y), pack2(y0.z, y0.w), pack2(y1.x, y1.y), pack2(y1.z, y1.w)); \
    } else {                                                                           \
      ra0 = *(const uint4*)((const u16*)Abase + (long)ar0 * lda + (k0) + lc * 8);      \
      ra1 = *(const uint4*)((const u16*)Abase + (long)ar1 * lda + (k0) + lc * 8);      \
    }                                                                                  \
    rb0 = *(const uint4*)(bp0 + (k0));                                                 \
    rb1 = *(const uint4*)(bp1 + (k0));                                                 \
  }
#define GEMM_STORE(buf)                                                 \
  {                                                                     \
    *(uint4*)(As + ((buf) * 128 + lr) * 32 + wsw) = ra0;             \
    *(uint4*)(As + ((buf) * 128 + lr + 64) * 32 + wsw) = ra1;        \
    *(uint4*)(Bs + ((buf) * 128 + lr) * 32 + wsw) = rb0;             \
    *(uint4*)(Bs + ((buf) * 128 + lr + 64) * 32 + wsw) = rb1;        \
  }
#pragma unroll
  for (int i = 0; i < 4; ++i)
#pragma unroll
    for (int j = 0; j < 4; ++j) acc[i][j] = f32x4{0.f, 0.f, 0.f, 0.f};
#define GEMM_COMPUTE(buf)                                                                                   \
  {                                                                                                         \
    bf16x8 af[4], bfr[4];                                                                                   \
    _Pragma("unroll") for (int i = 0; i < 4; ++i) {                                                         \
      af[i] = *(const bf16x8*)(As + ((buf) * 128 + 64 * wr + 16 * i + c) * 32 + rsw);                       \
      bfr[i] = *(const bf16x8*)(Bs + ((buf) * 128 + 64 * wc + 16 * i + c) * 32 + rsw);                      \
    }                                                                                                       \
    __builtin_amdgcn_s_setprio(1);                                                                          \
    _Pragma("unroll") for (int i = 0; i < 4; ++i)                                                           \
      _Pragma("unroll") for (int j = 0; j < 4; ++j)                                                         \
        acc[i][j] = SWAP ? MFMA(bfr[j], af[i], acc[i][j]) : MFMA(af[i], bfr[j], acc[i][j]);                 \
    __builtin_amdgcn_s_setprio(0);                                                                          \
    __builtin_amdgcn_sched_group_barrier(0x100, 8, 0);                                                      \
    __builtin_amdgcn_sched_group_barrier(0x008, 16, 0);                                                     \
  }
  const int nk = K >> 5;
  if (AF32) {
    GEMM_LOAD(0);
    GEMM_STORE(0);
    __syncthreads();
    for (int kt = 0; kt < nk; ++kt) {
      const int buf = kt & 1;
      GEMM_LOAD(min((kt + 1) * 32, K - 32));
      GEMM_COMPUTE(buf);
      GEMM_STORE(buf ^ 1);
      __syncthreads();
    }
  } else {
    uint4 sa0, sa1, sb0, sb1;
#define GEMM_LOAD2(k0)                                                              \
  {                                                                                 \
    sa0 = *(const uint4*)((const u16*)Abase + (long)ar0 * lda + (k0) + lc * 8);     \
    sa1 = *(const uint4*)((const u16*)Abase + (long)ar1 * lda + (k0) + lc * 8);     \
    sb0 = *(const uint4*)(bp0 + (k0));                                              \
    sb1 = *(const uint4*)(bp1 + (k0));                                              \
  }
#define GEMM_STORE2(buf)                                          \
  {                                                               \
    *(uint4*)(As + ((buf) * 128 + lr) * 32 + wsw) = sa0;          \
    *(uint4*)(As + ((buf) * 128 + lr + 64) * 32 + wsw) = sa1;     \
    *(uint4*)(Bs + ((buf) * 128 + lr) * 32 + wsw) = sb0;          \
    *(uint4*)(Bs + ((buf) * 128 + lr + 64) * 32 + wsw) = sb1;     \
  }
    const int klast = K - 32;
    GEMM_LOAD(0);
    GEMM_LOAD2(32);
    GEMM_STORE(0);
    __syncthreads();
    for (int kt = 0; kt < nk; kt += 2) {
      GEMM_LOAD(min((kt + 2) * 32, klast));
      GEMM_COMPUTE(0);
      GEMM_STORE2(1);
      __syncthreads();
      GEMM_LOAD2(min((kt + 3) * 32, klast));
      GEMM_COMPUTE(1);
      GEMM_STORE(0);
      __syncthreads();
    }
#undef GEMM_LOAD2
#undef GEMM_STORE2
  }
#undef GEMM_COMPUTE
#undef GEMM_LOAD
#undef GEMM_STORE
}

#define EPI_COORDS                                                             \
  const int tid = my_tid(), l = tid & 63, w = tid >> 6, c = l & 15, g = l >> 4; \
  const int wr = w >> 1, wc = w & 1;                                           \
  const int rbase = m0 + 64 * wr + 4 * g, cbase = n0 + 64 * wc + c;

template <bool SWAP = false>
DI void gemm_main8(const u16* Abase, long lda, const u16* Bt, long ldb, int K, f32x4 (&acc)[8][4], char* smem) {
  const int tid = my_tid(), l = tid & 63, w = tid >> 6, c = l & 15, g = l >> 4;
  const int wr = w >> 1, wc = w & 1;
  const int lr = tid >> 2, lc = tid & 3;
  u16* As = (u16*)smem;
  u16* Bs = As + 2 * 256 * 32;
  const int wsw = (lc ^ ((0 - (lr >> 2)) & 3)) * 8;
  const int rsw = (g ^ ((0 - (c >> 2)) & 3)) * 8;
  const u16* ap = Abase + (long)lr * lda + lc * 8;
  const u16* bp = Bt + (long)lr * ldb + lc * 8;
  uint4 xa0, xa1, xa2, xa3, xb0, xb1;
  uint4 ya0, ya1, ya2, ya3, yb0, yb1;
#define GEMM8_LOAD(S, k0)                                \
  {                                                      \
    S##a0 = *(const uint4*)(ap + (k0));                  \
    S##a1 = *(const uint4*)(ap + 64 * lda + (k0));       \
    S##a2 = *(const uint4*)(ap + 128 * lda + (k0));      \
    S##a3 = *(const uint4*)(ap + 192 * lda + (k0));      \
    S##b0 = *(const uint4*)(bp + (k0));                  \
    S##b1 = *(const uint4*)(bp + 64 * ldb + (k0));       \
  }
#define GEMM8_STORE(S, buf)                                              \
  {                                                                      \
    *(uint4*)(As + ((buf) * 256 + lr) * 32 + wsw) = S##a0;            \
    *(uint4*)(As + ((buf) * 256 + lr + 64) * 32 + wsw) = S##a1;       \
    *(uint4*)(As + ((buf) * 256 + lr + 128) * 32 + wsw) = S##a2;      \
    *(uint4*)(As + ((buf) * 256 + lr + 192) * 32 + wsw) = S##a3;      \
    *(uint4*)(Bs + ((buf) * 128 + lr) * 32 + wsw) = S##b0;            \
    *(uint4*)(Bs + ((buf) * 128 + lr + 64) * 32 + wsw) = S##b1;       \
  }
#define GEMM8_COMPUTE(buf)                                                                        \
  {                                                                                               \
    bf16x8 bfr[4], af[8];                                                                         \
    _Pragma("unroll") for (int i = 0; i < 4; ++i) bfr[i] =                                        \
        *(const bf16x8*)(Bs + ((buf) * 128 + 64 * wc + 16 * i + c) * 32 + rsw);                   \
    _Pragma("unroll") for (int i = 0; i < 8; ++i) af[i] =                                         \
        *(const bf16x8*)(As + ((buf) * 256 + 128 * wr + 16 * i + c) * 32 + rsw);                  \
    __builtin_amdgcn_s_setprio(1);                                                                \
    _Pragma("unroll") for (int i = 0; i < 8; ++i) {                                               \
      _Pragma("unroll") for (int j = 0; j < 4; ++j) acc[i][j] = SWAP ? MFMA(bfr[j], af[i], acc[i][j]) : MFMA(af[i], bfr[j], acc[i][j]); \
    }                                                                                             \
    __builtin_amdgcn_s_setprio(0);                                                                \
    __builtin_amdgcn_sched_group_barrier(0x100, 12, 0);                                           \
    __builtin_amdgcn_sched_group_barrier(0x008, 32, 0);                                           \
  }
#pragma unroll
  for (int i = 0; i < 8; ++i)
#pragma unroll
    for (int j = 0; j < 4; ++j) acc[i][j] = f32x4{0.f, 0.f, 0.f, 0.f};
  const int nk = K >> 5;
  GEMM8_LOAD(x, 0);
  GEMM8_LOAD(y, 32);
  GEMM8_STORE(x, 0);
  __syncthreads();
  const int klast = K - 32;
  for (int kt = 0; kt < nk; kt += 2) {
    GEMM8_LOAD(x, min((kt + 2) * 32, klast));
    GEMM8_COMPUTE(0);
    GEMM8_STORE(y, 1);
    __syncthreads();
    GEMM8_LOAD(y, min((kt + 3) * 32, klast));
    GEMM8_COMPUTE(1);
    GEMM8_STORE(x, 0);
    __syncthreads();
  }
#undef GEMM8_COMPUTE
#undef GEMM8_LOAD
#undef GEMM8_STORE
}

#define EPI_COORDS8                                                            \
  const int tid = my_tid(), l = tid & 63, w = tid >> 6, c = l & 15, g = l >> 4; \
  const int wr = w >> 1, wc = w & 1;                                           \
  const int rbase = m0 + 128 * wr + 4 * g, cbase = n0 + 64 * wc + c;

#define EPI_COORDS_S(WM)                                                       \
  const int tid = my_tid(), l = tid & 63, w = tid >> 6, c = l & 15, g = l >> 4; \
  const int wr = w >> 1, wc = w & 1;                                           \
  const int rrow = m0 + (WM) * wr + c, ccol = n0 + 64 * wc + 4 * g;

DI float rs_from_ssq(const float* ssq, long m) { return rsqrtf(ssq[m] * (1.f / 1024.f) + 1e-6f); }

DI void decode_xcd(int tile, int NT, int& mt, int& nt) {
  const int xcd = tile & 7, j = tile >> 3;
  mt = (j / NT) * 8 + xcd;
  nt = j % NT;
}

DI float lg_head(int h) { return log1pf(-exp2f(-5.f - (float)h)); }

DI void ret_qkv_tile(const Params& p, int tile, char* smem) {
  int mt, nt;
  decode_xcd(tile, 32, mt, nt);
  const int m0 = mt * 256, n0 = nt * 128;
  f32x4 acc[8][4];
  gemm_main8((const u16*)(p.ws + OFF_XB) + (long)m0 * 1024, 1024, wsW(p) + W_RET_IN + (long)n0 * 1024, 1024, 1024, acc, smem);
  EPI_COORDS8
  const float* rs = (const float*)(p.ws + OFF_RS);
  if (n0 < 2048) {
    const int part = n0 >> 10, head = (n0 & 1023) >> 8;
    const int dpb = (n0 & 255) + 64 * wc;
    const float lgh = lg_head(head);
    u16* Q = (u16*)(p.ws + OFF_Q);
    u16* Kb = (u16*)(p.ws + OFF_K);
    u16* Ktd = (u16*)(p.ws + OFF_KTD);
#pragma unroll
    for (int a = 0; a < 2; ++a) {
      const int dp1 = dpb + 32 * a + c, dp2 = dp1 + 16;
      const int i = ((dpb + 32 * a) >> 1) + c;
      const float ir = exp2f(-(float)i * (13.287712379549449f / 128.0f)) * 0.15915494309189535f;
#pragma unroll
      for (int ti = 0; ti < 8; ++ti) {
        float y1[4], y2[4];
        const int mrow0 = rbase + 16 * ti;
        const int b = mrow0 >> 14;
        const int t0 = mrow0 & (T - 1);
#pragma unroll
        for (int j = 0; j < 4; ++j) {
          const int t = t0 + j;
          const float r = rs[mrow0 + j];
          const float x1 = acc[ti][2 * a][j] * r, x2 = acc[ti][2 * a + 1][j] * r;
          const float tf = (float)t;
          const float pr_ = tf * ir;
          const float er_ = fmaf(tf, ir, -pr_);
          const float rf = (pr_ - floorf(pr_)) + er_;
          const float sn = __builtin_amdgcn_sinf(rf), cs = __builtin_amdgcn_cosf(rf);
          y1[j] = x1 * cs - x2 * sn;
          y2[j] = x1 * sn + x2 * cs;
        }
        const long bh = (long)b * 4 + head;
        if (part == 0) {
#pragma unroll
          for (int j = 0; j < 4; ++j) {
            Q[(bh * T + t0 + j) * 256 + dp1] = f2bf(y1[j]);
            Q[(bh * T + t0 + j) * 256 + dp2] = f2bf(y2[j]);
          }
        } else {
          float kd[4];
#pragma unroll
          for (int j = 0; j < 4; ++j) {
            y1[j] *= 0.0625f;
            y2[j] *= 0.0625f;
            Kb[(bh * T + t0 + j) * 256 + dp1] = f2bf(y1[j]);
            Kb[(bh * T + t0 + j) * 256 + dp2] = f2bf(y2[j]);
            kd[j] = __expf((float)(127 - ((t0 + j) & 127)) * lgh);
          }
          *(uint2*)(Ktd + ((bh * 128 + (t0 >> 7)) * 256 + dp1) * 128 + (t0 & 127)) = pack4h(y1[0] * kd[0], y1[1] * kd[1], y1[2] * kd[2], y1[3] * kd[3]);
          *(uint2*)(Ktd + ((bh * 128 + (t0 >> 7)) * 256 + dp2) * 128 + (t0 & 127)) = pack4h(y2[0] * kd[0], y2[1] * kd[1], y2[2] * kd[2], y2[3] * kd[3]);
        }
        __builtin_amdgcn_sched_barrier(0);
      }
    }
  } else {
    u16* Vt = (u16*)(p.ws + OFF_VT);
#pragma unroll
    for (int ti = 0; ti < 8; ++ti) {
      const int mrow0 = rbase + 16 * ti;
      const int b = mrow0 >> 14, t0 = mrow0 & (T - 1);
      const float r0 = rs[mrow0], r1 = rs[mrow0 + 1], r2 = rs[mrow0 + 2], r3 = rs[mrow0 + 3];
#pragma unroll
      for (int tj = 0; tj < 4; ++tj) {
        const int nv = cbase + 16 * tj - 2048;
        const int head = nv >> 9, dv = nv & 511;
        *(uint2*)(Vt + ((((long)b * 4 + head) * 128 + (t0 >> 7)) * 512 + dv) * 128 + (t0 & 127)) =
            pack4h(acc[ti][tj][0] * r0, acc[ti][tj][1] * r1, acc[ti][tj][2] * r2, acc[ti][tj][3] * r3);
      }
    }
  }
}

DI void ret_p_tile(const Params& p, int z, char* smem) {
  const int bh = z >> 7, head = bh & 3;
  const u16* Q = (const u16*)(p.ws + OFF_Q) + (long)z * 128 * 256;
  const u16* Kb = (const u16*)(p.ws + OFF_K) + (long)z * 128 * 256;
  f32x4 acc[4][4];
  gemm_main<false, true>(Q, 256, 128, Kb, 256, 256, acc, smem);
  const int m0 = 0, n0 = 0;
  EPI_COORDS_S(64)
  const float lgh = lg_head(head);
  u16* P = (u16*)(p.ws + OFF_P) + (long)z * 128 * 128;
#pragma unroll
  for (int ti = 0; ti < 4; ++ti) {
    const int n = rrow + 16 * ti;
#pragma unroll
    for (int tj = 0; tj < 4; ++tj) {
      const int mb = ccol + 16 * tj;
      float v[4];
#pragma unroll
      for (int jj = 0; jj < 4; ++jj) v[jj] = (n >= mb + jj) ? acc[ti][tj][jj] * __expf((float)(n - mb - jj) * lgh) : 0.f;
      *(uint2*)(P + n * 128 + mb) = pack4h(v[0], v[1], v[2], v[3]);
    }
  }
}

DI void ret_scan_item(const Params& p, int item, char* smem) {
  const int tid = my_tid(), l = tid & 63, w = tid >> 6, c = l & 15, g = l >> 4;
  const int bh = item & 7, sl = item >> 3;
  const int b = bh >> 2, head = bh & 3;
  const int dv0 = sl * 16;
  const float lgh = lg_head(head);
  const float cdec = __expf(128.f * lgh);
  u16* S = (u16*)smem;
  for (int i = tid; i < 16 * 264; i += 256) S[i] = 0;
  __syncthreads();
  const u16* Q = (const u16*)(p.ws + OFF_Q) + (long)bh * T * 256;
  const u16* Ktd = (const u16*)(p.ws + OFF_KTD) + (long)bh * 256 * T;
  const u16* Vt = (const u16*)(p.ws + OFF_VT) + (long)bh * 512 * T + (long)(dv0 + c) * 128;
  const u16* P = (const u16*)(p.ws + OFF_P) + (long)bh * 128 * 128 * 128;
  u16* O = (u16*)p.out;
  f32x4 st[4];
#pragma unroll
  for (int i = 0; i < 4; ++i) st[i] = f32x4{0.f, 0.f, 0.f, 0.f};
  float qd[2][4];
#pragma unroll
  for (int r2 = 0; r2 < 2; ++r2)
#pragma unroll
    for (int j = 0; j < 4; ++j) qd[r2][j] = __expf((float)(32 * w + 16 * r2 + 4 * g + j + 1) * lgh);
  bf16x8 vb[4], pf[2][4], qa[2][8], kf[4][4];
#define SCAN_LOAD(chn)                                                                                          \
  {                                                                                                             \
    const int tn_ = (chn) * 128;                                                                                \
    _Pragma("unroll") for (int ks = 0; ks < 4; ++ks) vb[ks] = *(const bf16x8*)(Vt + (long)(chn) * 65536 + 32 * ks + 8 * g);     \
    _Pragma("unroll") for (int r2 = 0; r2 < 2; ++r2) {                                                          \
      const u16* pr_ = P + ((long)(chn) * 128 + 32 * w + 16 * r2 + c) * 128 + 8 * g;                            \
      _Pragma("unroll") for (int ks = 0; ks < 4; ++ks) pf[r2][ks] = *(const bf16x8*)(pr_ + 32 * ks);            \
      const u16* qr_ = Q + (long)(tn_ + 32 * w + 16 * r2 + c) * 256 + 8 * g;                                    \
      _Pragma("unroll") for (int k8 = 0; k8 < 8; ++k8) qa[r2][k8] = *(const bf16x8*)(qr_ + 32 * k8);            \
    }                                                                                                           \
    _Pragma("unroll") for (int rt = 0; rt < 4; ++rt) {                                                          \
      const u16* kr_ = Ktd + (long)(chn) * 32768 + (64 * w + 16 * rt + c) * 128 + 8 * g;                                    \
      _Pragma("unroll") for (int ks = 0; ks < 4; ++ks) kf[rt][ks] = *(const bf16x8*)(kr_ + 32 * ks);            \
    }                                                                                                           \
  }
  SCAN_LOAD(0);
  for (int ch = 0; ch < 128; ++ch) {
    const int t0 = ch * 128;
    f32x4 apv[2], aqs[2];
#pragma unroll
    for (int r2 = 0; r2 < 2; ++r2) {
      apv[r2] = f32x4{0.f, 0.f, 0.f, 0.f};
      aqs[r2] = f32x4{0.f, 0.f, 0.f, 0.f};
#pragma unroll
      for (int ks = 0; ks < 4; ++ks) apv[r2] = MFMA(pf[r2][ks], vb[ks], apv[r2]);
    }
#pragma unroll
    for (int k8 = 0; k8 < 8; ++k8) {
      const bf16x8 sb = *(const bf16x8*)(S + c * 264 + 32 * k8 + 8 * g);
#pragma unroll
      for (int r2 = 0; r2 < 2; ++r2) aqs[r2] = MFMA(qa[r2][k8], sb, aqs[r2]);
    }
#pragma unroll
    for (int rt = 0; rt < 4; ++rt) {
      st[rt] *= cdec;
#pragma unroll
      for (int ks = 0; ks < 4; ++ks) st[rt] = MFMA(kf[rt][ks], vb[ks], st[rt]);
    }
    __builtin_amdgcn_sched_barrier(0);
    SCAN_LOAD(min(ch + 1, 127));
    __builtin_amdgcn_sched_barrier(0);
#pragma unroll
    for (int r2 = 0; r2 < 2; ++r2)
#pragma unroll
      for (int j = 0; j < 4; ++j) {
        const int n = 32 * w + 16 * r2 + 4 * g + j;
        const float v = apv[r2][j] + qd[r2][j] * aqs[r2][j];
        O[((long)b * T + t0 + n) * 2048 + head * 512 + dv0 + c] = f2bf(v);
      }
    lds_barrier();
#pragma unroll
    for (int rt = 0; rt < 4; ++rt)
      *(uint2*)(S + c * 264 + 64 * w + 16 * rt + 4 * g) = pack4(st[rt][0], st[rt][1], st[rt][2], st[rt][3]);
    lds_barrier();
  }
#undef SCAN_LOAD
}

DI void ret_gate_tile(const Params& p, int tile, char* smem) {
  int mt, nt;
  decode_xcd(tile, 16, mt, nt);
  const int m0 = mt * 256, n0 = nt * 128;
  f32x4 acc[8][4];
  gemm_main8<true>((const u16*)(p.ws + OFF_XB) + (long)m0 * 1024, 1024, wsW(p) + W_RET_IN + (long)(4096 + n0) * 1024, 1024, 1024, acc, smem);
  EPI_COORDS_S(128)
  const float* rs = (const float*)(p.ws + OFF_RS);
  const float* stats = (const float*)(p.ws + OFF_STATS);
  const u16* O = (const u16*)p.out;
  u16* A2 = (u16*)(p.ws + OFF_A2);
  const int head = n0 >> 9;
  float4 gn[4];
#pragma unroll
  for (int tj = 0; tj < 4; ++tj) gn[tj] = *(const float4*)(p.ret_gn + ccol + 16 * tj);
#pragma unroll
  for (int hh = 0; hh < 2; ++hh) {
    float r[4];
    float2 st[4];
    uint2 ov[4][4];
#pragma unroll
    for (int t4 = 0; t4 < 4; ++t4) {
      const long m = rrow + 16 * (4 * hh + t4);
      r[t4] = rs[m];
      st[t4] = *(const float2*)(stats + (m * 4 + head) * 2);
#pragma unroll
      for (int tj = 0; tj < 4; ++tj) ov[t4][tj] = *(const uint2*)(O + m * 2048 + ccol + 16 * tj);
    }
    __builtin_amdgcn_sched_barrier(0);
#pragma unroll
    for (int t4 = 0; t4 < 4; ++t4) {
      const int ti = 4 * hh + t4;
      const long m = rrow + 16 * ti;
      const float mu = st[t4].x, rstd = st[t4].y;
#pragma unroll
      for (int tj = 0; tj < 4; ++tj) {
        const uint2 o = ov[t4][tj];
        const float o0 = __uint_as_float(o.x << 16), o1 = __uint_as_float(o.x & 0xffff0000u);
        const float o2 = __uint_as_float(o.y << 16), o3 = __uint_as_float(o.y & 0xffff0000u);
        const float g0 = acc[ti][tj][0] * r[t4], g1 = acc[ti][tj][1] * r[t4], g2 = acc[ti][tj][2] * r[t4], g3 = acc[ti][tj][3] * r[t4];
        *(uint2*)(A2 + m * 2048 + ccol + 16 * tj) =
            pack4h(g0 * sigmoidf_(g0) * (o0 - mu) * rstd * gn[tj].x, g1 * sigmoidf_(g1) * (o1 - mu) * rstd * gn[tj].y,
                  g2 * sigmoidf_(g2) * (o2 - mu) * rstd * gn[tj].z, g3 * sigmoidf_(g3) * (o3 - mu) * rstd * gn[tj].w);
      }
    }
    __builtin_amdgcn_sched_barrier(0);
  }
}

DI void ret_out_tile(const Params& p, int tile, char* smem) {
  int mt, nt;
  decode_xcd(tile, 8, mt, nt);
  const int m0 = mt * 256, n0 = nt * 128;
  f32x4 acc[8][4];
  gemm_main8<true>((const u16*)(p.ws + OFF_A2) + (long)m0 * 2048, 2048, wsW(p) + W_RET_OUT + (long)n0 * 2048, 2048, 2048, acc, smem);
  EPI_COORDS_S(128)
#pragma unroll
  for (int hh = 0; hh < 2; ++hh) {
    float4 xv[4][4];
#pragma unroll
    for (int t4 = 0; t4 < 4; ++t4)
#pragma unroll
      for (int tj = 0; tj < 4; ++tj) xv[t4][tj] = ld_nt4(p.x + (long)(rrow + 16 * (4 * hh + t4)) * 1024 + ccol + 16 * tj);
    __builtin_amdgcn_sched_barrier(0);
#pragma unroll
    for (int t4 = 0; t4 < 4; ++t4) {
      const int ti = 4 * hh + t4;
      const long m = rrow + 16 * ti;
      float ss = 0.f;
#pragma unroll
      for (int tj = 0; tj < 4; ++tj) {
        const int n = ccol + 16 * tj;
        const float4 h = make_float4(xv[t4][tj].x + acc[ti][tj][0], xv[t4][tj].y + acc[ti][tj][1], xv[t4][tj].z + acc[ti][tj][2],
                                     xv[t4][tj].w + acc[ti][tj][3]);
        *(float4*)(p.out + m * 1024 + n) = h;
        *(uint2*)((u16*)(p.ws + OFF_XB) + m * 1024 + n) = pack4h(h.x, h.y, h.z, h.w);
        ss += h.x * h.x + h.y * h.y + h.z * h.z + h.w * h.w;
      }
      ss = xsum16(xsum32(ss));
      if (g == 0) atomicAdd((float*)(p.ws + OFF_SSQ1) + m, ss);
    }
    __builtin_amdgcn_sched_barrier(0);
  }
}

DI void ple_tile(const Params& p, int layer, int tile, char* smem) {
  int mt, nt;
  decode_xcd(tile, 8, mt, nt);
  const int m0 = mt * 128, n0 = nt * 128;
  f32x4 ae[4][4], ag[4][4];
  gemm_main<true, true>(p.p + ((long)layer * M + m0) * 256, 256, 128, wsW(p) + W_PE + (long)layer * 1024 * 256 + (long)n0 * 256, 256, 256, ae, smem);
  gemm_main<false, true>((const u16*)(p.ws + OFF_XB) + (long)m0 * 1024, 1024, 128, wsW(p) + W_PG + (long)layer * 1024 * 1024 + (long)n0 * 1024, 1024, 1024, ag, smem);
  EPI_COORDS_S(64)
  const float* ssq_in = (const float*)(p.ws + (layer == 0 ? OFF_SSQ1 : OFF_SSQ3));
  float rq[4];
  float4 hv[4][4];
#pragma unroll
  for (int ti = 0; ti < 4; ++ti) {
    rq[ti] = ssq_in[rrow + 16 * ti];
#pragma unroll
    for (int tj = 0; tj < 4; ++tj) hv[ti][tj] = *(const float4*)(p.out + (long)(rrow + 16 * ti) * 1024 + ccol + 16 * tj);
  }
  __builtin_amdgcn_sched_barrier(0);
#pragma unroll
  for (int ti = 0; ti < 4; ++ti) {
    const long m = rrow + 16 * ti;
    const float r = rsqrtf(rq[ti] * (1.f / 1024.f) + 1e-6f);
    float ss = 0.f;
#pragma unroll
    for (int tj = 0; tj < 4; ++tj) {
      float4 h = hv[ti][tj];
      h.x += sigmoidf_(ag[ti][tj][0] * r) * ae[ti][tj][0];
      h.y += sigmoidf_(ag[ti][tj][1] * r) * ae[ti][tj][1];
      h.z += sigmoidf_(ag[ti][tj][2] * r) * ae[ti][tj][2];
      h.w += sigmoidf_(ag[ti][tj][3] * r) * ae[ti][tj][3];
      *(float4*)(p.out + m * 1024 + ccol + 16 * tj) = h;
      if (layer == 0) {
        *(uint2*)((u16*)(p.ws + OFF_XB2) + m * 1024 + ccol + 16 * tj) = pack4(h.x, h.y, h.z, h.w);
        ss += h.x * h.x + h.y * h.y + h.z * h.z + h.w * h.w;
      }
    }
    if (layer == 0) {
      ss = xsum16(xsum32(ss));
      if (g == 0) atomicAdd((float*)(p.ws + OFF_SSQ2) + m, ss);
    }
  }
}

DI u16* kvpart(const Params& p, int part) { return (u16*)(p.ws + OFF_KV + (long)part * 32 * MiB); }

DI void kv_tile(const Params& p, int tile, char* smem) {
  int mt, nt;
  decode_xcd(tile, 24, mt, nt);
  const int m0 = mt * 256, n0 = nt * 128;
  const float* ssq = (const float*)(p.ws + OFF_SSQ2);
  const int part = nt >> 2, grp = nt & 3;
  u16* dst = kvpart(p, part);
  const bool transposed = (part == 3) || (part == 5);
  f32x4 acc[8][4];
  if (transposed) {
    gemm_main8<false>((const u16*)(p.ws + OFF_XB2) + (long)m0 * 1024, 1024, wsW(p) + W_KV + (long)n0 * 1024, 1024, 1024, acc, smem);
    EPI_COORDS8
#pragma unroll
    for (int ti = 0; ti < 8; ++ti) {
      const int mrow0 = rbase + 16 * ti;
      const int b = mrow0 >> 14, t0 = mrow0 & (T - 1);
      const long bg = (long)b * 4 + grp;
      const float r0 = rs_from_ssq(ssq, mrow0), r1 = rs_from_ssq(ssq, mrow0 + 1), r2 = rs_from_ssq(ssq, mrow0 + 2), r3 = rs_from_ssq(ssq, mrow0 + 3);
#pragma unroll
      for (int tj = 0; tj < 4; ++tj) {
        const int d = 64 * wc + 16 * tj + c;
        *(uint2*)(dst + ((bg * 256 + (t0 >> 6)) * 128 + d) * 64 + (t0 & 63)) =
            pack4h(acc[ti][tj][0] * r0, acc[ti][tj][1] * r1, acc[ti][tj][2] * r2, acc[ti][tj][3] * r3);
      }
    }
  } else {
    gemm_main8<true>((const u16*)(p.ws + OFF_XB2) + (long)m0 * 1024, 1024, wsW(p) + W_KV + (long)n0 * 1024, 1024, 1024, acc, smem);
    EPI_COORDS_S(128)
#pragma unroll
    for (int ti = 0; ti < 8; ++ti) {
      const int m = rrow + 16 * ti;
      const int b = m >> 14, t = m & (T - 1);
      const float r = rs_from_ssq(ssq, m);
      u16* q = dst + (((long)b * 4 + grp) * T + t) * 128 + 64 * wc + 4 * g;
#pragma unroll
      for (int tj = 0; tj < 4; ++tj)
        *(uint2*)(q + 16 * tj) = pack4h(acc[ti][tj][0] * r, acc[ti][tj][1] * r, acc[ti][tj][2] * r, acc[ti][tj][3] * r);
    }
  }
}

DI void nsaq_tile(const Params& p, int tile, char* smem) {
  int mt, nt;
  decode_xcd(tile, 17, mt, nt);
  const int m0 = mt * 256, n0 = nt * 128;
  f32x4 acc[8][4];
  gemm_main8<true>((const u16*)(p.ws + OFF_XB2) + (long)m0 * 1024, 1024, wsW(p) + W_NSA + (long)n0 * 1024, 1024, 1024, acc, smem);
  EPI_COORDS_S(128)
  const float* ssq = (const float*)(p.ws + OFF_SSQ2);
  u16* Qn = (u16*)(p.ws + OFF_QN);
  float* gates = (float*)(p.ws + OFF_GATES);
  const float qscale = 0.08838834764831845f * 1.4426950408889634f;
#pragma unroll
  for (int ti = 0; ti < 8; ++ti) {
    const long m = rrow + 16 * ti;
    const float r = rs_from_ssq(ssq, m);
#pragma unroll
    for (int tj = 0; tj < 4; ++tj) {
      const int n = ccol + 16 * tj;
      const float v0 = acc[ti][tj][0] * r, v1 = acc[ti][tj][1] * r, v2 = acc[ti][tj][2] * r, v3 = acc[ti][tj][3] * r;
      if (n < 2048) *(uint2*)(Qn + m * 2048 + n) = pack4h(v0 * qscale, v1 * qscale, v2 * qscale, v3 * qscale);
      else if (n < 2096) *(float4*)(gates + m * 48 + (n - 2048)) = make_float4(sigmoidf_(v0), sigmoidf_(v1), sigmoidf_(v2), sigmoidf_(v3));
    }
  }
}

DI float gelu_tanh(float x) {
  const float u = 0.7978845608028654f * (x + 0.044715f * x * x * x);
  return 0.5f * x * (1.f + tanhf(u));
}

DI void cmp1_tile(const Params& p, int tile, char* smem) {
  const int z = tile >> 4, mt = (tile >> 1) & 7, nt = tile & 1;
  const int kind = z >> 3, bg = z & 7;
  const int m0 = mt * 128, n0 = nt * 128;
  const u16* A = kvpart(p, kind) + (long)bg * T * 128 + (long)m0 * 2048;
  f32x4 acc[4][4];
  gemm_main<false>(A, 2048, 1023 - m0, wsW(p) + (kind ? W_C1V : W_C1K) + (long)n0 * 4096, 4096, 4096, acc, smem);
  EPI_COORDS
  const float* bpart = (const float*)(p.ws + OFF_BIAS) + kind * 32 * 256;
  u16* H = (u16*)(p.ws + OFF_H) + (long)z * 1024 * 256;
  float bias[4];
#pragma unroll
  for (int tj = 0; tj < 4; ++tj) {
    float bs = 0.f;
    for (int q = 0; q < 32; ++q) bs += bpart[q * 256 + cbase + 16 * tj];
    bias[tj] = bs;
  }
#pragma unroll
  for (int ti = 0; ti < 4; ++ti)
#pragma unroll
    for (int j = 0; j < 4; ++j) {
      const int m = rbase + 16 * ti + j;
#pragma unroll
      for (int tj = 0; tj < 4; ++tj) {
        const int n = cbase + 16 * tj;
        const float v = (m < 1023) ? gelu_tanh(acc[ti][tj][j] + bias[tj]) : 0.f;
        H[(long)m * 256 + n] = f2bf(v);
      }
    }
}

DI void cmp2_tile(const Params& p, int tile, char* smem) {
  const int z = tile >> 3, mt = tile & 7;
  const int kind = z >> 3, bg = z & 7;
  const int m0 = mt * 128, n0 = 0;
  const u16* A = (const u16*)(p.ws + OFF_H) + (long)z * 1024 * 256 + (long)m0 * 256;
  f32x4 acc[4][4];
  gemm_main<false>(A, 256, 128, wsW(p) + (kind ? W_C2V : W_C2K), 256, 256, acc, smem);
  EPI_COORDS
  if (kind == 0) {
    u16* Kc = (u16*)(p.ws + OFF_KCMP) + (long)bg * 1024 * 128;
#pragma unroll
    for (int ti = 0; ti < 4; ++ti)
#pragma unroll
      for (int j = 0; j < 4; ++j) {
        const int m = rbase + 16 * ti + j;
#pragma unroll
        for (int tj = 0; tj < 4; ++tj) Kc[(long)m * 128 + cbase + 16 * tj] = f2bf(m < 1023 ? acc[ti][tj][j] : 0.f);
      }
  } else {
    u16* Vc = (u16*)(p.ws + OFF_VCMPT) + (long)bg * 128 * 1024;
#pragma unroll
    for (int ti = 0; ti < 4; ++ti) {
      const int mrow0 = rbase + 16 * ti;
#pragma unroll
      for (int tj = 0; tj < 4; ++tj) {
        const int n = cbase + 16 * tj;
        const float v3 = (mrow0 + 3 < 1023) ? acc[ti][tj][3] : 0.f;
        *(uint2*)(Vc + ((long)(mrow0 >> 6) * 128 + n) * 64 + (mrow0 & 63)) = pack4(acc[ti][tj][0], acc[ti][tj][1], acc[ti][tj][2], v3);
      }
    }
  }
}

DI void nsa_gate_tile(const Params& p, int tile, char* smem) {
  int mt, nt;
  decode_xcd(tile, 16, mt, nt);
  const int m0 = mt * 256, n0 = nt * 128;
  f32x4 acc[8][4];
  gemm_main8<true>((const u16*)(p.ws + OFF_XB2) + (long)m0 * 1024, 1024, wsW(p) + W_NSA + (long)(2176 + n0) * 1024, 1024, 1024, acc, smem);
  EPI_COORDS_S(128)
  const float* ssq = (const float*)(p.ws + OFF_SSQ2);
  u16* O = (u16*)(p.ws + OFF_QN);
#pragma unroll
  for (int hh = 0; hh < 2; ++hh) {
    float r[4];
    uint2 ov[4][4];
#pragma unroll
    for (int t4 = 0; t4 < 4; ++t4) {
      const long m = rrow + 16 * (4 * hh + t4);
      r[t4] = ssq[m];
#pragma unroll
      for (int tj = 0; tj < 4; ++tj) ov[t4][tj] = *(const uint2*)(O + m * 2048 + ccol + 16 * tj);
    }
    __builtin_amdgcn_sched_barrier(0);
#pragma unroll
    for (int t4 = 0; t4 < 4; ++t4) {
      const int ti = 4 * hh + t4;
      const long m = rrow + 16 * ti;
      const float rr = rsqrtf(r[t4] * (1.f / 1024.f) + 1e-6f);
#pragma unroll
      for (int tj = 0; tj < 4; ++tj) {
        const uint2 o = ov[t4][tj];
        const float o0 = __uint_as_float(o.x << 16), o1 = __uint_as_float(o.x & 0xffff0000u);
        const float o2 = __uint_as_float(o.y << 16), o3 = __uint_as_float(o.y & 0xffff0000u);
        const float g0 = acc[ti][tj][0] * rr, g1 = acc[ti][tj][1] * rr, g2 = acc[ti][tj][2] * rr, g3 = acc[ti][tj][3] * rr;
        *(uint2*)(O + m * 2048 + ccol + 16 * tj) = pack4h(g0 * sigmoidf_(g0) * o0, g1 * sigmoidf_(g1) * o1, g2 * sigmoidf_(g2) * o2, g3 * sigmoidf_(g3) * o3);
      }
    }
    __builtin_amdgcn_sched_barrier(0);
  }
}

DI void nsa_out_tile(const Params& p, int tile, char* smem) {
  int mt, nt;
  decode_xcd(tile, 8, mt, nt);
  const int m0 = mt * 256, n0 = nt * 128;
  f32x4 acc[8][4];
  gemm_main8<true>((const u16*)(p.ws + OFF_QN) + (long)m0 * 2048, 2048, wsW(p) + W_NSA_OUT + (long)n0 * 2048, 2048, 2048, acc, smem);
  EPI_COORDS_S(128)
#pragma unroll
  for (int hh = 0; hh < 2; ++hh) {
    float4 hv[4][4];
#pragma unroll
    for (int t4 = 0; t4 < 4; ++t4)
#pragma unroll
      for (int tj = 0; tj < 4; ++tj) hv[t4][tj] = *(const float4*)(p.out + (long)(rrow + 16 * (4 * hh + t4)) * 1024 + ccol + 16 * tj);
    __builtin_amdgcn_sched_barrier(0);
#pragma unroll
    for (int t4 = 0; t4 < 4; ++t4) {
      const int ti = 4 * hh + t4;
      const long m = rrow + 16 * ti;
      float ss = 0.f;
#pragma unroll
      for (int tj = 0; tj < 4; ++tj) {
        float4 h = hv[t4][tj];
        h.x += acc[ti][tj][0]; h.y += acc[ti][tj][1]; h.z += acc[ti][tj][2]; h.w += acc[ti][tj][3];
        *(float4*)(p.out + m * 1024 + ccol + 16 * tj) = h;
        *(uint2*)((u16*)(p.ws + OFF_XB) + m * 1024 + ccol + 16 * tj) = pack4h(h.x, h.y, h.z, h.w);
        ss += h.x * h.x + h.y * h.y + h.z * h.z + h.w * h.w;
      }
      ss = xsum16(xsum32(ss));
      if (g == 0) atomicAdd((float*)(p.ws + OFF_SSQ3) + m, ss);
    }
    __builtin_amdgcn_sched_barrier(0);
  }
}

DI void wave_lds_fence() {
  __builtin_amdgcn_wave_barrier();
  asm volatile("s_waitcnt lgkmcnt(0)" ::: "memory");
  __builtin_amdgcn_wave_barrier();
}

DI bf16x8 pack8_mfma(float a0, float a1, float a2, float a3, float a4, float a5, float a6, float a7) {
  u32 p0, p1, p2, p3;
  asm volatile("v_cvt_pk_bf16_f32 %0, %4, %5\n\tv_cvt_pk_bf16_f32 %1, %6, %7\n\tv_cvt_pk_bf16_f32 %2, %8, %9\n\tv_cvt_pk_bf16_f32 %3, %10, %11\n\ts_nop 1"
               : "=&v"(p0), "=&v"(p1), "=&v"(p2), "=&v"(p3)
               : "v"(a0), "v"(a1), "v"(a2), "v"(a3), "v"(a4), "v"(a5), "v"(a6), "v"(a7));
  return __builtin_bit_cast(bf16x8, make_uint4(p0, p1, p2, p3));
}

constexpr int NSA_IMP_OFF = 32768;
constexpr int NSA_IMP_WAVE = 8 * 260 * 4;
constexpr int NSA_MASK_OFF = NSA_IMP_OFF + 4 * NSA_IMP_WAVE;
constexpr int SMEM_BYTES = NSA_MASK_OFF + 1024;

enum { NSA_SEL = 0, NSA_WIN = 1, NSA_CMP1 = 2, NSA_CMP2 = 3 };

template <int MODE, int u>
DI void nsa_block_compute(const char* stage, u32 m8, int j, const bf16x8 (&qf)[4], f32x4 (&O)[8], float& mrun, float& lrun, int tbase,
                          float invl, float& carry_in, float* imp, int l, int w, int c, int g) {
  const u32 mu = (m8 >> (4 * u)) & 0xfu;
  if (!mu) return;
  const int t = tbase + 8 * w + 4 * u + (c >> 2);
  const bool colok = (mu >> (c >> 2)) & 1u;
  int hi, lo;
  if (MODE == NSA_SEL) { hi = t; lo = -1; }
  else if (MODE == NSA_WIN) { hi = t; lo = t - 512; }
  else { hi = max(0, (t - 15) >> 4) - 1; lo = -1; }
  if (!colok) { hi = -1; lo = 0; }
  f32x4 s[4];
#pragma unroll
  for (int half = 0; half < 2; ++half) {
    const int r0 = 32 * half + 8 * (c >> 2) + (c & 3);
    s[2 * half] = f32x4{0.f, 0.f, 0.f, 0.f};
    s[2 * half + 1] = f32x4{0.f, 0.f, 0.f, 0.f};
    bf16x8 ka[8];
#pragma unroll
    for (int ds = 0; ds < 4; ++ds) {
      ka[2 * ds] = *(const bf16x8*)(stage + (r0 * 16 + ((4 * ds + g) ^ c)) * 16);
      ka[2 * ds + 1] = *(const bf16x8*)(stage + ((r0 + 4) * 16 + ((4 * ds + g) ^ c)) * 16);
    }
#pragma unroll
    for (int ds = 0; ds < 4; ++ds) {
      s[2 * half] = MFMA(ka[2 * ds], qf[ds], s[2 * half]);
      s[2 * half + 1] = MFMA(ka[2 * ds + 1], qf[ds], s[2 * half + 1]);
    }
    __builtin_amdgcn_sched_group_barrier(0x100, 8, 0);
    __builtin_amdgcn_sched_group_barrier(0x008, 8, 0);
    __builtin_amdgcn_sched_barrier(0);
  }
  float v[16];
  bool ok[16];
  const int tmin = tbase + 8 * w + 4 * u, tmax = tmin + 3;
  bool interior;
  if (MODE == NSA_SEL) interior = (j * 64 + 63 <= tmin);
  else if (MODE == NSA_WIN) interior = (j * 64 + 63 <= tmin) && (j * 64 > tmax - 512);
  else interior = (j * 64 + 63 <= max(0, (tmin - 15) >> 4) - 1);
  if (interior) {
#pragma unroll
    for (int q = 0; q < 4; ++q)
#pragma unroll
      for (int jj = 0; jj < 4; ++jj) {
        ok[4 * q + jj] = colok;
        v[4 * q + jj] = s[q][jj];
      }
  } else {
#pragma unroll
    for (int q = 0; q < 4; ++q)
#pragma unroll
      for (int jj = 0; jj < 4; ++jj) {
        const int key = j * 64 + 32 * (q >> 1) + 8 * g + 4 * (q & 1) + jj;
        ok[4 * q + jj] = (key > lo) && (key <= hi);
        v[4 * q + jj] = ok[4 * q + jj] ? s[q][jj] : -1e30f;
      }
  }
  if (MODE == NSA_CMP2) {
#pragma unroll
    for (int i = 0; i < 16; ++i) {
      float pr = ok[i] ? __builtin_amdgcn_exp2f(v[i] - mrun) * invl : 0.f;
      pr += dpp_xor1(pr);
      pr += dpp_xor2(pr);
      v[i] = pr;
    }
#pragma unroll
    for (int half = 0; half < 2; ++half) {
      const float* pr = v + 8 * half;
      const float up = __shfl_up(pr[7], 16);
      const float last = __shfl(pr[7], 48 + c);
      const float cin = (g == 0) ? carry_in : up;
      carry_in = last;
      if ((c & 3) == 0) {
        const int bj = 16 * j + 8 * half + 2 * g;
        float* row = imp + (4 * u + (c >> 2)) * 260;
        row[bj] = 2.f * (pr[0] + pr[1] + pr[2]) + pr[3] + cin;
        row[bj + 1] = 2.f * (pr[4] + pr[5] + pr[6]) + pr[7] + pr[3];
      }
    }
    return;
  }
  float mx = v[0];
#pragma unroll
  for (int i = 1; i < 16; ++i) mx = fmaxf(mx, v[i]);
  if (interior) mx = colok ? mx : -1e30f;
  mx = xmax16(xmax32(mx));
  const float mnew = fmaxf(mrun, mx);
  const float alpha = __builtin_amdgcn_exp2f(mrun - mnew);
  mrun = mnew;
  float ls = 0.f;
  if (interior) {
    const float meff = colok ? mnew : 1e30f;
#pragma unroll
    for (int i = 0; i < 16; ++i) {
      v[i] = __builtin_amdgcn_exp2f(v[i] - meff);
      ls += v[i];
    }
  } else {
#pragma unroll
    for (int i = 0; i < 16; ++i) {
      v[i] = ok[i] ? __builtin_amdgcn_exp2f(v[i] - mnew) : 0.f;
      ls += v[i];
    }
  }
  lrun = lrun * alpha + ls;
  if (__builtin_amdgcn_ballot_w64(alpha != 1.f)) {
#pragma unroll
    for (int d = 0; d < 8; ++d) O[d] *= alpha;
  }
  __builtin_amdgcn_sched_barrier(0);
#pragma unroll
  for (int half = 0; half < 2; ++half) {
    const bf16x8 pb = pack8_mfma(v[8 * half], v[8 * half + 1], v[8 * half + 2], v[8 * half + 3], v[8 * half + 4], v[8 * half + 5],
                                 v[8 * half + 6], v[8 * half + 7]);
    bf16x8 va[8];
#pragma unroll
    for (int d = 0; d < 8; ++d) va[d] = *(const bf16x8*)(stage + 16384 + ((16 * d + c) * 8 + ((4 * half + g) ^ ((c >> 1) & 7))) * 16);
#pragma unroll
    for (int d = 0; d < 8; ++d) O[d] = MFMA(va[d], pb, O[d]);
    __builtin_amdgcn_sched_group_barrier(0x100, 8, 0);
    __builtin_amdgcn_sched_group_barrier(0x008, 8, 0);
    __builtin_amdgcn_sched_barrier(0);
  }
}

DI int next_set256(unsigned long long n0, unsigned long long n1, unsigned long long n2, unsigned long long n3, int from) {
  if (from >= 256) return 256;
  const int wd = from >> 6, sh = from & 63;
  unsigned long long b0 = (wd == 0) ? (n0 >> sh) << sh : 0ull;
  unsigned long long b1 = (wd <= 1) ? ((wd == 1) ? (n1 >> sh) << sh : n1) : 0ull;
  unsigned long long b2 = (wd <= 2) ? ((wd == 2) ? (n2 >> sh) << sh : n2) : 0ull;
  unsigned long long b3 = (wd == 3) ? (n3 >> sh) << sh : n3;
  if (b0) return __builtin_ctzll(b0);
  if (b1) return 64 + __builtin_ctzll(b1);
  if (b2) return 128 + __builtin_ctzll(b2);
  if (b3) return 192 + __builtin_ctzll(b3);
  return 256;
}

template <int MODE>
DI void nsa_block_loop(const u16* Kg, const u16* Vg, int jfirst, int jlast, const u32* selmask, char* stage,
                       const bf16x8 (&qf)[2][4], f32x4 (&O)[2][8], float (&mrun)[2], float (&lrun)[2], int tbase,
                       const float (&invl)[2], float* imp, int) {
  const int tid = my_tid(), l = tid & 63, w = tid >> 6, c = l & 15, g = l >> 4;
  const int krow = tid >> 2, kcq = tid & 3, vrow = tid >> 1, vcq = tid & 1;
  const int khs = (krow & 3) | (((krow >> 3) & 3) << 2);
  const int vhs = (vrow >> 1) & 7;
  constexpr bool HASV = (MODE != NSA_CMP2);
  constexpr bool MASKED = (MODE == NSA_SEL);
  uint4 kr0, kr1, kr2, kr3, vr0, vr1, vr2, vr3;
  float cin0 = 0.f, cin1 = 0.f;
  int j = jfirst;
  unsigned long long nz0 = 0, nz1 = 0, nz2 = 0, nz3 = 0;
  u32 mcur = 0u;
  if (MASKED) {
    nz0 = __builtin_amdgcn_ballot_w64(selmask[l] != 0u);
    nz1 = __builtin_amdgcn_ballot_w64(selmask[64 + l] != 0u);
    nz2 = __builtin_amdgcn_ballot_w64(selmask[128 + l] != 0u);
    nz3 = __builtin_amdgcn_ballot_w64(selmask[192 + l] != 0u);
    j = next_set256(nz0, nz1, nz2, nz3, jfirst);
    if (j <= jlast) mcur = selmask[j];
  }
#define NSA_LOADBLK(jj)                                                    \
  {                                                                        \
    const uint4* ks = (const uint4*)(Kg + (long)(jj) * 8192 + tid * 32);    \
    kr0 = ks[0]; kr1 = ks[1]; kr2 = ks[2]; kr3 = ks[3];                     \
    if (HASV) {                                                            \
      const uint4* vs = (const uint4*)(Vg + (long)(jj) * 8192 + tid * 32);  \
      vr0 = vs[0]; vr1 = vs[1]; vr2 = vs[2]; vr3 = vs[3];                   \
    }                                                                      \
  }
  if (j <= jlast) NSA_LOADBLK(j);
  while (j <= jlast) {
    *(uint4*)(stage + (krow * 16 + ((4 * kcq + 0) ^ khs)) * 16) = kr0;
    *(uint4*)(stage + (krow * 16 + ((4 * kcq + 1) ^ khs)) * 16) = kr1;
    *(uint4*)(stage + (krow * 16 + ((4 * kcq + 2) ^ khs)) * 16) = kr2;
    *(uint4*)(stage + (krow * 16 + ((4 * kcq + 3) ^ khs)) * 16) = kr3;
    if (HASV) {
      *(uint4*)(stage + 16384 + (vrow * 8 + ((4 * vcq + 0) ^ vhs)) * 16) = vr0;
      *(uint4*)(stage + 16384 + (vrow * 8 + ((4 * vcq + 1) ^ vhs)) * 16) = vr1;
      *(uint4*)(stage + 16384 + (vrow * 8 + ((4 * vcq + 2) ^ vhs)) * 16) = vr2;
      *(uint4*)(stage + 16384 + (vrow * 8 + ((4 * vcq + 3) ^ vhs)) * 16) = vr3;
    }
    __syncthreads();
    int jn = j + 1;
    u32 mnext = 0u;
    if (MASKED) {
      jn = next_set256(nz0, nz1, nz2, nz3, j + 1);
      mnext = selmask[min(jn, 255)];
    }
    NSA_LOADBLK(jn <= jlast ? jn : j);
    u32 m8 = 0xffu;
    if (MASKED) m8 = (__builtin_amdgcn_readfirstlane(mcur) >> (8 * w)) & 0xffu;
    nsa_block_compute<MODE, 0>(stage, m8, j, qf[0], O[0], mrun[0], lrun[0], tbase, invl[0], cin0, imp, l, w, c, g);
    nsa_block_compute<MODE, 1>(stage, m8, j, qf[1], O[1], mrun[1], lrun[1], tbase, invl[1], cin1, imp, l, w, c, g);
    __syncthreads();
    j = jn;
    mcur = mnext;
  }
#undef NSA_LOADBLK
  if (MODE == NSA_CMP2) {
    if (jlast >= jfirst && g == 0 && (c & 3) == 0) {
      imp[(c >> 2) * 260 + 16 * (jlast + 1)] = cin0;
      imp[(4 + (c >> 2)) * 260 + 16 * (jlast + 1)] = cin1;
    }
  }
}

#define NSA_RECOORD                                                                                      \
  const int tid_ = my_tid(), l_ = tid_ & 63, w_ = tid_ >> 6, c_ = l_ & 15, g_ = l_ >> 4;                   \
  const int head_ = grp * 4 + (c_ & 3);                                                                  \
  const int mrow_ = b * T + tbase + 8 * w_ + (c_ >> 2);                                                  \
  f32x4* scr_ = (f32x4*)(p.ws + OFF_KV) + (((long)blockIdx.x * 4 + w_) * 64 + l_) * 16;                  \
  (void)g_; (void)head_; (void)mrow_; (void)scr_;
DI void nsa_item(const Params& p, int item, char* smem) {
  const int tid = my_tid(), l = tid & 63, w = tid >> 6, c = l & 15, g = l >> 4;
  int bg, tile;
  if (gridDim.x == 512) {
    const int k = item >> 9, q = (item & 511) >> 3;
    const int base = q + 64 * (k >> 1);
    bg = item & 7;
    const int flip = (int)(blockIdx.x >> 8) & 1;
    tile = ((k & 1) ^ flip) ? base : 511 - base;
  } else {
    bg = item >> 9;
    const int s512 = item & 511;
    tile = (bg & 1) ? 511 - s512 : s512;
  }
  const int b = bg >> 2, grp = bg & 3;
  const int tbase = tile * 32;
  const int cur = tbase >> 6;
  const int head = grp * 4 + (c & 3);
  float* imp = (float*)(smem + NSA_IMP_OFF + w * NSA_IMP_WAVE);
  u32* selmask = (u32*)(smem + NSA_MASK_OFF);
  u16* Qn = (u16*)(p.ws + OFF_QN);
  const float* gates = (const float*)(p.ws + OFF_GATES);

  selmask[tid] = 0u;
  for (int i = l; i < 8 * 260; i += 64) imp[i] = 0.f;
  __syncthreads();

  bf16x8 qf[2][4];
  const int mrow0 = b * T + tbase + 8 * w + (c >> 2);
#pragma unroll
  for (int u = 0; u < 2; ++u) {
#pragma unroll
    for (int ds = 0; ds < 4; ++ds) qf[u][ds] = *(const bf16x8*)(Qn + (long)(mrow0 + 4 * u) * 2048 + head * 128 + 32 * ds + 8 * g);
  }
  f32x4 O[2][8];
  float mrun[2], lrun[2], invl[2];
#pragma unroll
  for (int u = 0; u < 2; ++u) {
    mrun[u] = -1e30f;
    lrun[u] = 0.f;
    invl[u] = 0.f;
#pragma unroll
    for (int d = 0; d < 8; ++d) O[u][d] = f32x4{0.f, 0.f, 0.f, 0.f};
  }
  const int ncvmax = max(0, (tbase + 31 - 15) >> 4);
  const int nbc = (ncvmax + 63) >> 6;
  const u16* Kc = (const u16*)(p.ws + OFF_KCMP) + (long)bg * 1024 * 128;
  const u16* Vc = (const u16*)(p.ws + OFF_VCMPT) + (long)bg * 128 * 1024;
  nsa_block_loop<NSA_CMP1>(Kc, Vc, 0, nbc - 1, selmask, smem, qf, O, mrun, lrun, tbase, invl, imp, tid);
  {
    NSA_RECOORD
#pragma unroll
    for (int u = 0; u < 2; ++u) {
      const float ltot = xsum16(xsum32(lrun[u]));
      invl[u] = ltot > 0.f ? 1.f / ltot : 0.f;
      const float gc = gates[(mrow_ + 4 * u) * 48 + head_ * 3 + 0] * invl[u];
#pragma unroll
      for (int d = 0; d < 8; ++d) {
        scr_[u * 8 + d] = O[u][d] * gc;
        O[u][d] = f32x4{0.f, 0.f, 0.f, 0.f};
      }
    }
  }
  nsa_block_loop<NSA_CMP2>(Kc, Vc, 0, nbc - 1, selmask, smem, qf, O, mrun, lrun, tbase, invl, imp, tid);
  wave_lds_fence();
  for (int tk = 0; tk < 8; ++tk) {
    const int tt = tbase + 8 * w + tk;
    u32 key[4];
#pragma unroll
    for (int e = 0; e < 4; ++e) {
      const int j = l + 64 * e;
      const float v = imp[tk * 260 + j];
      const bool forced = (j == 0) || (j == cur) || (j == cur - 1);
      const float sc = forced ? 1e30f : fmaxf(v, 0.f);
      key[e] = (j <= cur) ? ((__float_as_uint(sc) & ~0x1ffu) | ((u32)(255 - j) << 1) | 1u) : 0u;
    }
    u32 ans = 0u;
    for (int bit = 31; bit >= 0; --bit) {
      const u32 cand = ans | (1u << bit);
      int cnt = 0;
#pragma unroll
      for (int e = 0; e < 4; ++e) cnt += __builtin_popcountll(__builtin_amdgcn_ballot_w64(key[e] >= cand));
      if (cnt >= 16) ans = cand;
    }
#pragma unroll
    for (int e = 0; e < 4; ++e)
      if (key[e] != 0u && key[e] >= ans) atomicOr(&selmask[l + 64 * e], 1u << (8 * w + tk));
  }
  __syncthreads();

#pragma unroll
  for (int u = 0; u < 2; ++u) {
    mrun[u] = -1e30f;
    lrun[u] = 0.f;
  }
  nsa_block_loop<NSA_SEL>(kvpart(p, 2) + (long)bg * T * 128, kvpart(p, 3) + (long)bg * 256 * 128 * 64, 0, cur, selmask, smem, qf, O, mrun,
                          lrun, tbase, invl, imp, tid);
  {
    NSA_RECOORD
#pragma unroll
    for (int u = 0; u < 2; ++u) {
      const float ltot = xsum16(xsum32(lrun[u]));
      const float gs = gates[(mrow_ + 4 * u) * 48 + head_ * 3 + 1] / ltot;
#pragma unroll
      for (int d = 0; d < 8; ++d) {
        f32x4 a = scr_[u * 8 + d];
        a += O[u][d] * gs;
        scr_[u * 8 + d] = a;
        O[u][d] = f32x4{0.f, 0.f, 0.f, 0.f};
      }
      mrun[u] = -1e30f;
      lrun[u] = 0.f;
    }
  }
  nsa_block_loop<NSA_WIN>(kvpart(p, 4) + (long)bg * T * 128, kvpart(p, 5) + (long)bg * 256 * 128 * 64, max(0, tbase - 511) >> 6, cur,
                          selmask, smem, qf, O, mrun, lrun, tbase, invl, imp, tid);
  {
    NSA_RECOORD
#pragma unroll
    for (int u = 0; u < 2; ++u) {
      const float ltot = xsum16(xsum32(lrun[u]));
      const float gw = gates[(mrow_ + 4 * u) * 48 + head_ * 3 + 2] / ltot;
#pragma unroll
      for (int d = 0; d < 8; ++d) {
        f32x4 a = scr_[u * 8 + d];
        a += O[u][d] * gw;
        *(uint2*)(Qn + (long)(mrow_ + 4 * u) * 2048 + head_ * 128 + 16 * d + 4 * g_) = pack4(a[0], a[1], a[2], a[3]);
      }
    }
  }
}
#undef NSA_RECOORD

#define XB_TMO      128
#define XB_XCNT(j)  (256  + 64 * (j))
#define XB_XSUB(j)  (1280 + 64 * (j))
#define XB_XGEN(j)  (2304 + 64 * (j))
#define XB_TOP      3328
#define XB_TOPGEN   3392
#define XCD_BAR_WORDS 3456
#define XB_SPIN_CAP (1u << 18)
#define LAS __attribute__((address_space(3)))

__device__ __forceinline__ unsigned xb_ld(unsigned* p)              { return __hip_atomic_load(p, __ATOMIC_RELAXED, __HIP_MEMORY_SCOPE_AGENT); }
__device__ __forceinline__ unsigned xb_add(unsigned* p, unsigned v) { return __hip_atomic_fetch_add(p, v, __ATOMIC_RELAXED, __HIP_MEMORY_SCOPE_AGENT); }
__device__ __forceinline__ unsigned xb_xcc_id() { return (unsigned)__builtin_amdgcn_s_getreg((3 << 11) | 20) & 0xFu; }
#define XB_SPIN(cond, bar) do { unsigned _sp = 0; while (cond) { __builtin_amdgcn_s_sleep(1); \
    if ((++_sp & 255u) == 0u) { if (xb_ld(&(bar)[XB_TMO])) break; if (_sp > XB_SPIN_CAP) { atomicAdd(&(bar)[XB_TMO], 1u); break; } } } } while (0)

struct XcdBarrier {
    unsigned* bar; unsigned x;
    volatile LAS unsigned* st;
};

__device__ __forceinline__ XcdBarrier xcd_barrier_post(unsigned* bar, volatile LAS unsigned* st) {
    XcdBarrier b; b.bar = bar; b.x = xb_xcc_id(); b.st = st;
    if (threadIdx.x == 0) (void)xb_add(&bar[XB_XCNT(b.x)], 1u);
    return b;
}
__device__ __forceinline__ void xcd_barrier_complete(unsigned* bar, unsigned x, unsigned& nloc, unsigned& nx) {
    const unsigned G = gridDim.x * gridDim.y * gridDim.z;
    unsigned sum, cnt, mine, sp = 0u;
    for (;;) {
        sum = 0u; cnt = 0u; mine = 0u;
#pragma unroll
        for (unsigned j = 0; j < 16; ++j) { const unsigned c = xb_ld(&bar[XB_XCNT(j)]); sum += c; cnt += (c > 0u) ? 1u : 0u; mine = (j == x) ? c : mine; }
        if (sum == G) break;
        __builtin_amdgcn_s_sleep(1);
        if ((++sp & 255u) == 0u) { if (xb_ld(&bar[XB_TMO])) break; if (sp > XB_SPIN_CAP) { atomicAdd(&bar[XB_TMO], 1u); break; } }
    }
    nloc = mine > 0u ? mine : 1u; nx = cnt > 0u ? cnt : 1u;
}

__device__ __forceinline__ void xcd_barrier(const XcdBarrier& b) {
    asm volatile("s_waitcnt vmcnt(0)" ::: "memory");
    __syncthreads();
    if (threadIdx.x == 0) {
        unsigned* bar = b.bar;
        __builtin_amdgcn_s_waitcnt(0);
        unsigned nloc = b.st[0], nx = b.st[1];
        if (nloc == 0u) { xcd_barrier_complete(bar, b.x, nloc, nx); b.st[0] = nloc; b.st[1] = nx; }
        const unsigned old = xb_add(&bar[XB_XSUB(b.x)], 1u);
        const unsigned gen = old / nloc;
        if (old + 1u == (gen + 1u) * nloc) {
            __builtin_amdgcn_fence(__ATOMIC_RELEASE, "agent");
            asm volatile("s_waitcnt vmcnt(0)" ::: "memory");
            const unsigned og = xb_add(&bar[XB_TOP], 1u);
            const unsigned tg = og / nx;
            if (og + 1u == (tg + 1u) * nx) xb_add(&bar[XB_TOPGEN], 1u);
            else XB_SPIN(xb_ld(&bar[XB_TOPGEN]) == tg, bar);
            __builtin_amdgcn_fence(__ATOMIC_ACQUIRE, "agent");
            xb_add(&bar[XB_XGEN(b.x)], 1u);
            asm volatile("s_waitcnt vmcnt(0)" ::: "memory");
        } else {
            XB_SPIN(xb_ld(&bar[XB_XGEN(b.x)]) == gen, bar);
            __builtin_amdgcn_fence(__ATOMIC_ACQUIRE, "agent");
            asm volatile("s_waitcnt vmcnt(0)" ::: "memory");
        }
    }
    __syncthreads();
}


constexpr long OFF_XBAR = OFF_BIAS + 512 * 1024;

constexpr int NPHASE = 19;
DI void run_phase(const Params& p, int ph, char* smem) {
  const int bid = blockIdx.x, nb = gridDim.x;
#ifdef PH_ONLY
  if (ph != PH_ONLY) return;
  ph = PH_ONLY;
#endif
  switch (ph) {
    case 0: {
      for (int i = bid; i < CONV_TILES; i += nb) conv_tile(p, i, smem);
      {
        u32* z = (u32*)(wsW(p) + W_NSA + 2096l * 1024);
        for (int i = bid * 256 + my_tid(); i < 80 * 512; i += nb * 256) z[i] = 0u;
      }
      for (int i = bid; i < 64; i += nb) bias_item(p, i, smem);
      {
        float* z = (float*)(p.ws + OFF_SSQ1);
        for (int i = bid * 256 + my_tid(); i < 3 * 32768; i += nb * 256) z[i] = 0.f;
      }
      for (int i = bid; i < M / 4; i += nb) rownorm_item(p, p.x, i);
    } break;
    case 1: for (int i = bid; i < 128 * 32; i += nb) ret_qkv_tile(p, i, smem); break;
    case 2: for (int i = bid; i < 1024; i += nb) ret_p_tile(p, i, smem); break;
    case 3: for (int i = bid; i < 256; i += nb) ret_scan_item(p, i, smem); break;
    case 4: for (int i = bid; i < M / 4; i += nb) stats_item(p, i); break;
    case 5: for (int i = bid; i < 128 * 16; i += nb) ret_gate_tile(p, i, smem); break;
    case 6: for (int i = bid; i < 128 * 8; i += nb) ret_out_tile(p, i, smem); break;
    case 7: for (int i = bid; i < M / 4; i += nb) rownorm_item(p, p.out, i); break;
    case 8: for (int i = bid; i < 256 * 8; i += nb) ple_tile(p, 0, i, smem); break;
    case 9: for (int i = bid; i < M / 4; i += nb) rownorm_item(p, p.out, i); break;
    case 10: for (int i = bid; i < 128 * 24; i += nb) kv_tile(p, i, smem); break;
    case 11: {
      const int half = nb >> 1;
      if (bid < half) {
        for (int i = bid; i < 256; i += half) cmp1_tile(p, i, smem);
      } else {
        for (int i = bid - half; i < 128 * 17; i += nb - half) nsaq_tile(p, i, smem);
      }
    } break;
    case 12: for (int i = bid; i < 128; i += nb) cmp2_tile(p, i, smem); break;
    case 13: for (int i = bid; i < 8 * 512; i += nb) nsa_item(p, i, smem); break;
    case 14: for (int i = bid; i < 128 * 16; i += nb) nsa_gate_tile(p, i, smem); break;
    case 15: for (int i = bid; i < 128 * 8; i += nb) nsa_out_tile(p, i, smem); break;
    case 16: for (int i = bid; i < M / 4; i += nb) rownorm_item(p, p.out, i); break;
    case 17: for (int i = bid; i < 256 * 8; i += nb) ple_tile(p, 1, i, smem); break;
    default: for (int i = bid; i < M / 4; i += nb) finalnorm_item(p, i); break;
  }
}

#if !MEGA
__global__ void __launch_bounds__(256) k_phase(Params p, int ph) {
  __shared__ __attribute__((aligned(16))) char smem[SMEM_BYTES];
  run_phase(p, ph, smem);
}

#else
__global__ void __launch_bounds__(256, 2) k_mega(Params p) {
  __shared__ __attribute__((aligned(16))) char smem[SMEM_BYTES];
  cg::grid_group grid = cg::this_grid();
  __shared__ uint4 xb_words;
  if (threadIdx.x == 0) xb_words = make_uint4(0u, 0u, 0u, 0u);
  __syncthreads();
  XcdBarrier xb = xcd_barrier_post((unsigned*)(p.ws + OFF_XBAR), (volatile LAS unsigned*)&xb_words);
  if (p.ws == nullptr) grid.sync();
  run_phase(p, 0, smem);
  xcd_barrier(xb);
#define PH(n) run_phase(p, n, smem); xcd_barrier(xb);
  PH(1) PH(2) PH(3) PH(4) PH(5) PH(6) PH(8) PH(10) PH(11) PH(12) PH(13) PH(14) PH(15) PH(17)
#undef PH
  run_phase(p, 18, smem);
}
#endif

extern "C" void kernel_launch(void* const* d_in, const int* in_sizes, int n_in, void* d_out, int out_size, void* d_ws,
                              size_t ws_size, hipStream_t stream) {
  if (ws_size < (size_t)WS_NEED) {
    fprintf(stderr, "workspace too small: %zu\n", ws_size);
    return;
  }
  Params p{};
  const float** f = (const float**)&p;
  for (int i = 0; i < 21; ++i) f[i] = (const float*)d_in[i];
  p.out = (float*)d_out;
  p.ws = (char*)d_ws;
  static int grid_blocks = 0;
  if (!grid_blocks) {
    int dev = 0, cus = 0, per_cu = 0;
    (void)hipGetDevice(&dev);
    (void)hipDeviceGetAttribute(&cus, hipDeviceAttributeMultiprocessorCount, dev);
#if MEGA
    (void)hipOccupancyMaxActiveBlocksPerMultiprocessor(&per_cu, k_mega, 256, 0);
#else
    (void)hipOccupancyMaxActiveBlocksPerMultiprocessor(&per_cu, k_phase, 256, 0);
#endif
    if (per_cu < 1) per_cu = 1;
    grid_blocks = cus * per_cu;
    if (grid_blocks > 1024) grid_blocks = 1024;
  }
#if MEGA
  (void)hipMemsetAsync((char*)d_ws + OFF_XBAR, 0, XCD_BAR_WORDS * sizeof(unsigned), stream);
  void* args[] = {&p};
  hipError_t e = hipLaunchCooperativeKernel((void*)k_mega, dim3(grid_blocks), dim3(256), args, 0, stream);
  if (e != hipSuccess) fprintf(stderr, "cooperative launch failed: %s (grid %d)\n", hipGetErrorString(e), grid_blocks);
#else
  for (int ph = 0; ph < NPHASE; ++ph) k_phase<<<grid_blocks, 256, 0, stream>>>(p, ph);
#endif
}
```

```cpp
#include <hip/hip_runtime.h>
#include <hip/hip_cooperative_groups.h>
#include <cstdio>
namespace cg = cooperative_groups;

#ifndef MEGA
#define MEGA 1
#endif

typedef unsigned short u16;
typedef unsigned int u32;
using bf16x8 = __attribute__((ext_vector_type(8))) short;
using f32x4 = __attribute__((ext_vector_type(4))) float;
#define DI __device__ __forceinline__
#define MFMA(a, b, c) __builtin_amdgcn_mfma_f32_16x16x32_bf16((a), (b), (c), 0, 0, 0)

constexpr int T = 16384, M = 32768;
constexpr long MiB = 1l << 20;
constexpr long W_RET_IN = 0;
constexpr long W_RET_OUT = W_RET_IN + 6144l * 1024;
constexpr long W_KV = W_RET_OUT + 1024l * 2048;
constexpr long W_C1K = W_KV + 3072l * 1024;
constexpr long W_C1V = W_C1K + 256l * 4096;
constexpr long W_C2K = W_C1V + 256l * 4096;
constexpr long W_C2V = W_C2K + 128l * 256;
constexpr long W_NSA = W_C2V + 128l * 256;
constexpr long W_NSA_OUT = W_NSA + 4224l * 1024;
constexpr long W_PG = W_NSA_OUT + 1024l * 2048;
constexpr long W_PE = W_PG + 2l * 1024 * 1024;
constexpr long W_END = W_PE + 2l * 1024 * 256;
static_assert(W_END * 2 < 47 * MiB, "weights region");
constexpr long OFF_BIAS = 47 * MiB;
constexpr long OFF_XB = 48 * MiB, OFF_RS = 112 * MiB, OFF_STATS = 113 * MiB;
constexpr long OFF_Q = 114 * MiB, OFF_K = 178 * MiB, OFF_KTD = 242 * MiB, OFF_VT = 306 * MiB, OFF_P = 434 * MiB;
constexpr long OFF_A2 = OFF_Q;
constexpr long OFF_KV = 114 * MiB;
constexpr long OFF_QN = 306 * MiB;
constexpr long OFF_GATES = 48 * MiB, OFF_KCMP = 54 * MiB, OFF_VCMPT = 56 * MiB, OFF_H = 58 * MiB;
constexpr long OFF_XB2 = 434 * MiB;
constexpr long OFF_SSQ1 = OFF_RS + 128 * 1024, OFF_SSQ2 = OFF_RS + 256 * 1024, OFF_SSQ3 = OFF_RS + 384 * 1024;
constexpr long WS_NEED = 498 * MiB;

struct Params {
  const float *x, *p, *ret_norm, *ret_w_in, *ret_gn, *ret_w_out, *kv_norm, *kv_w, *cmp_pe_k, *cmp_w1_k, *cmp_w2_k,
      *cmp_pe_v, *cmp_w1_v, *cmp_w2_v, *nsa_norm, *nsa_w_in, *nsa_w_out, *ple_norm, *ple_w_gate, *ple_w_emb, *final_norm;
  float* out;
  char* ws;
};

DI int my_tid() {
  int t = threadIdx.x;
  asm volatile("" : "+v"(t));
  return t;
}
DI float xmax32(float x) {
  auto r = __builtin_amdgcn_permlane32_swap(__float_as_uint(x), __float_as_uint(x), false, false);
  return fmaxf(__uint_as_float(r[0]), __uint_as_float(r[1]));
}
DI float xmax16(float x) {
  auto r = __builtin_amdgcn_permlane16_swap(__float_as_uint(x), __float_as_uint(x), false, false);
  return fmaxf(__uint_as_float(r[0]), __uint_as_float(r[1]));
}
DI float xsum32(float x) {
  auto r = __builtin_amdgcn_permlane32_swap(__float_as_uint(x), __float_as_uint(x), false, false);
  return __uint_as_float(r[0]) + __uint_as_float(r[1]);
}
DI float xsum16(float x) {
  auto r = __builtin_amdgcn_permlane16_swap(__float_as_uint(x), __float_as_uint(x), false, false);
  return __uint_as_float(r[0]) + __uint_as_float(r[1]);
}
DI float dpp_xor1(float x) { return __int_as_float(__builtin_amdgcn_update_dpp(0, __float_as_int(x), 0xB1, 0xF, 0xF, true)); }
DI float dpp_xor2(float x) { return __int_as_float(__builtin_amdgcn_update_dpp(0, __float_as_int(x), 0x4E, 0xF, 0xF, true)); }

DI void lds_barrier() { asm volatile("s_waitcnt lgkmcnt(0)\n\ts_barrier" ::: "memory"); }
DI float4 ld_nt4(const float* p) {
  const f32x4 v = __builtin_nontemporal_load((const f32x4*)p);
  return make_float4(v[0], v[1], v[2], v[3]);
}
DI void st_nt4(float* p, float4 v) { __builtin_nontemporal_store(f32x4{v.x, v.y, v.z, v.w}, (f32x4*)p); }

DI u16 f2bf(float x) {
  u32 u = __float_as_uint(x);
  u += 0x7fffu + ((u >> 16) & 1u);
  return (u16)(u >> 16);
}
DI float bf2f(u16 h) { return __uint_as_float(((u32)h) << 16); }
DI u32 pack2(float a, float b) { return (u32)f2bf(a) | ((u32)f2bf(b) << 16); }
DI u32 pack2h(float a, float b) {
  u32 r;
  asm("v_cvt_pk_bf16_f32 %0, %1, %2" : "=v"(r) : "v"(a), "v"(b));
  return r;
}
DI uint2 pack4h(float a, float b, float c, float d) { return make_uint2(pack2h(a, b), pack2h(c, d)); }
DI uint2 pack4(float a, float b, float c, float d) { return make_uint2(pack2(a, b), pack2(c, d)); }
DI float sigmoidf_(float x) { return __builtin_amdgcn_rcpf(1.f + __expf(-x)); }
DI u16* wsW(const Params& p) { return (u16*)p.ws; }

struct ConvJob {
  const float* src;
  const float* gain;
  u16* dst;
  int K, N, mode, ntn;
};
DI ConvJob get_job(const Params& p, int j) {
  ConvJob c;
  u16* W = wsW(p);
  c.gain = nullptr;
  c.mode = 0;
  switch (j) {
    case 0: c.src = p.ret_w_in; c.gain = p.ret_norm; c.dst = W + W_RET_IN; c.K = 1024; c.N = 6144; c.mode = 1; break;
    case 1: c.src = p.ret_w_out; c.dst = W + W_RET_OUT; c.K = 2048; c.N = 1024; break;
    case 2: c.src = p.kv_w; c.gain = p.kv_norm; c.dst = W + W_KV; c.K = 1024; c.N = 3072; break;
    case 3: c.src = p.cmp_w1_k; c.dst = W + W_C1K; c.K = 4096; c.N = 256; break;
    case 4: c.src = p.cmp_w1_v; c.dst = W + W_C1V; c.K = 4096; c.N = 256; break;
    case 5: c.src = p.cmp_w2_k; c.dst = W + W_C2K; c.K = 256; c.N = 128; break;
    case 6: c.src = p.cmp_w2_v; c.dst = W + W_C2V; c.K = 256; c.N = 128; break;
    case 7: c.src = p.nsa_w_in; c.gain = p.nsa_norm; c.dst = W + W_NSA; c.K = 1024; c.N = 4144; c.mode = 2; break;
    case 8: c.src = p.nsa_w_out; c.dst = W + W_NSA_OUT; c.K = 2048; c.N = 1024; break;
    case 9: c.src = p.ple_w_gate; c.gain = p.ple_norm; c.dst = W + W_PG; c.K = 1024; c.N = 1024; break;
    case 10: c.src = p.ple_w_gate + 1024l * 1024; c.gain = p.ple_norm + 1024; c.dst = W + W_PG + 1024l * 1024; c.K = 1024; c.N = 1024; break;
    case 11: c.src = p.ple_w_emb; c.dst = W + W_PE; c.K = 256; c.N = 1024; break;
    default: c.src = p.ple_w_emb + 256l * 1024; c.dst = W + W_PE + 1024l * 256; c.K = 256; c.N = 1024; break;
  }
  c.ntn = (c.N + 63) >> 6;
  return c;
}
DI int conv_ntiles(int j) {
  switch (j) {
    case 0: return 16 * 96;
    case 1: return 32 * 16;
    case 2: return 16 * 48;
    case 3: case 4: return 64 * 4;
    case 5: case 6: return 4 * 2;
    case 7: return 16 * 65;
    case 8: return 32 * 16;
    case 9: case 10: return 16 * 16;
    default: return 4 * 16;
  }
}
constexpr int CONV_TILES = 1536 + 512 + 768 + 512 + 16 + 1040 + 512 + 512 + 128;

DI int conv_dst_row(int mode, int n) {
  if (mode == 1) {
    if (n >= 2048) return n;
    int part = n >> 10, nn = n & 1023, head = nn >> 8, d = nn & 255, s = d >> 7, i = d & 127;
    return part * 1024 + head * 256 + 32 * (i >> 4) + 16 * s + (i & 15);
  } else if (mode == 2) {
    if (n < 2048) return n;
    if (n < 4096) return 2176 + (n - 2048);
    return 2048 + (n - 4096);
  }
  return n;
}

DI void conv_tile(const Params& p, int tile, char* smem) {
  int j = 0;
  for (; j < 12; ++j) {
    int nt = conv_ntiles(j);
    if (tile < nt) break;
    tile -= nt;
  }
  ConvJob cj = get_job(p, j);
  const int tk = tile / cj.ntn, tn = tile % cj.ntn;
  const int k0 = tk * 64, n0 = tn * 64;
  float* tl = (float*)smem;
  const int tid = my_tid();
  {
    const int r = tid >> 4, c4 = tid & 15;
    const int n = n0 + 4 * c4;
#pragma unroll
    for (int i = 0; i < 4; ++i) {
      const int k = r + 16 * i;
      float4 v = make_float4(0.f, 0.f, 0.f, 0.f);
      if (n < cj.N) v = ld_nt4(cj.src + (long)(k0 + k) * cj.N + n);
      float* d = tl + k * 65 + 4 * c4;
      d[0] = v.x; d[1] = v.y; d[2] = v.z; d[3] = v.w;
    }
  }
  __syncthreads();
  {
    const int nn = tid >> 2, kq = tid & 3;
    const int n = n0 + nn;
    if (n < cj.N) {
      const int row = conv_dst_row(cj.mode, n);
      u32 o[8];
#pragma unroll
      for (int i = 0; i < 8; ++i) {
        const int k = 16 * kq + 2 * i;
        float a = tl[k * 65 + nn], b = tl[(k + 1) * 65 + nn];
        if (cj.gain) { a *= cj.gain[k0 + k]; b *= cj.gain[k0 + k + 1]; }
        o[i] = pack2(a, b);
      }
      uint4* dst = (uint4*)(cj.dst + (long)row * cj.K + k0 + 16 * kq);
      dst[0] = make_uint4(o[0], o[1], o[2], o[3]);
      dst[1] = make_uint4(o[4], o[5], o[6], o[7]);
    }
  }
  __syncthreads();
}

DI void bias_item(const Params& p, int item, char* smem) {
  const int kind = item >> 5, kq = item & 31;
  const float* pe = kind ? p.cmp_pe_v : p.cmp_pe_k;
  const float* w1 = kind ? p.cmp_w1_v : p.cmp_w1_k;
  const int n = my_tid();
  float s0 = 0.f, s1 = 0.f, s2 = 0.f, s3 = 0.f;
#pragma unroll 8
  for (int k = kq * 128; k < (kq + 1) * 128; k += 4) {
    s0 += pe[k] * w1[(long)k * 256 + n];
    s1 += pe[k + 1] * w1[(long)(k + 1) * 256 + n];
    s2 += pe[k + 2] * w1[(long)(k + 2) * 256 + n];
    s3 += pe[k + 3] * w1[(long)(k + 3) * 256 + n];
  }
  ((float*)(p.ws + OFF_BIAS))[(kind * 32 + kq) * 256 + n] = (s0 + s1) + (s2 + s3);
}

DI void rownorm_item(const Params& p, const float* h, int item) {
  const int l = my_tid() & 63, w = my_tid() >> 6;
  const int row = item * 4 + w;
  const float* src = h + (long)row * 1024;
  u16* xb = (u16*)(p.ws + OFF_XB) + (long)row * 1024;
  float ss = 0.f;
#pragma unroll
  for (int i = 0; i < 4; ++i) {
    float4 v = *(const float4*)(src + 256 * i + 4 * l);
    ss += v.x * v.x + v.y * v.y + v.z * v.z + v.w * v.w;
    *(uint2*)(xb + 256 * i + 4 * l) = pack4(v.x, v.y, v.z, v.w);
  }
#pragma unroll
  for (int o = 32; o >= 1; o >>= 1) ss += __shfl_xor(ss, o);
  if (l == 0) ((float*)(p.ws + OFF_RS))[row] = rsqrtf(ss * (1.f / 1024.f) + 1e-6f);
}

DI void finalnorm_item(const Params& p, int item) {
  const int l = my_tid() & 63, w = my_tid() >> 6;
  const int row = item * 4 + w;
  float* src = p.out + (long)row * 1024;
  float4 v[4];
  float ss = 0.f;
#pragma unroll
  for (int i = 0; i < 4; ++i) {
    v[i] = ld_nt4(src + 256 * i + 4 * l);
    ss += v[i].x * v[i].x + v[i].y * v[i].y + v[i].z * v[i].z + v[i].w * v[i].w;
  }
#pragma unroll
  for (int o = 32; o >= 1; o >>= 1) ss += __shfl_xor(ss, o);
  const float rs = rsqrtf(ss * (1.f / 1024.f) + 1e-6f);
#pragma unroll
  for (int i = 0; i < 4; ++i) {
    float4 gg = *(const float4*)(p.final_norm + 256 * i + 4 * l);
    float4 o = make_float4(v[i].x * rs * gg.x, v[i].y * rs * gg.y, v[i].z * rs * gg.z, v[i].w * rs * gg.w);
    st_nt4(src + 256 * i + 4 * l, o);
  }
}

DI void stats_item(const Params& p, int item) {
  const int l = my_tid() & 63, w = my_tid() >> 6;
  const int row = item * 4 + w;
  const u16* o = (const u16*)p.out + (long)row * 2048 + 32 * l;
  float v[32];
#pragma unroll
  for (int i = 0; i < 4; ++i) {
    uint4 q = *(const uint4*)(o + 8 * i);
    u32 u[4] = {q.x, q.y, q.z, q.w};
#pragma unroll
    for (int e = 0; e < 4; ++e) {
      v[8 * i + 2 * e] = __uint_as_float(u[e] << 16);
      v[8 * i + 2 * e + 1] = __uint_as_float(u[e] & 0xffff0000u);
    }
  }
  float s = 0.f;
#pragma unroll
  for (int i = 0; i < 32; ++i) s += v[i];
#pragma unroll
  for (int o2 = 8; o2 >= 1; o2 >>= 1) s += __shfl_xor(s, o2);
  const float mu = s * (1.f / 512.f);
  float q2 = 0.f;
#pragma unroll
  for (int i = 0; i < 32; ++i) { float d = v[i] - mu; q2 += d * d; }
#pragma unroll
  for (int o2 = 8; o2 >= 1; o2 >>= 1) q2 += __shfl_xor(q2, o2);
  if ((l & 15) == 0) {
    float* st = (float*)(p.ws + OFF_STATS) + ((long)row * 4 + (l >> 4)) * 2;
    st[0] = mu;
    st[1] = rsqrtf(q2 * (1.f / 512.f) + 1e-6f);
  }
}

template <bool AF32, bool SWAP = false>
DI void gemm_main(const void* Abase, long lda, int a_valid, const u16* Bt, long ldb, int K, f32x4 (&acc)[4][4], char* smem) {
  const int tid = my_tid(), l = tid & 63, w = tid >> 6, c = l & 15, g = l >> 4;
  const int wr = w >> 1, wc = w & 1;
  const int lr = tid >> 2, lc = tid & 3;
  u16* As = (u16*)smem;
  u16* Bs = As + 2 * 128 * 32;
  const int wsw = (lc ^ ((0 - (lr >> 2)) & 3)) * 8;
  const int rsw = (g ^ ((0 - (c >> 2)) & 3)) * 8;
  const int ar0 = min(lr, a_valid - 1), ar1 = min(lr + 64, a_valid - 1);
  const u16* bp0 = Bt + (long)lr * ldb + lc * 8;
  const u16* bp1 = Bt + (long)(lr + 64) * ldb + lc * 8;
  uint4 ra0, ra1, rb0, rb1;
#define GEMM_LOAD(k0)                                                                  \
  {                                                                                    \
    if (AF32) {                                                                        \
      const float* a0 = (const float*)Abase + (long)ar0 * lda + (k0) + lc * 8;         \
      const float* a1 = (const float*)Abase + (long)ar1 * lda + (k0) + lc * 8;         \
      float4 x0 = ld_nt4(a0), x1 = ld_nt4(a0 + 4);                                     \
      float4 y0 = ld_nt4(a1), y1 = ld_nt4(a1 + 4);                                     \
      ra0 = make_uint4(pack2(x0.x, x0.y), pack2(x0.z, x0.w), pack2(x1.x, x1.y), pack2(x1.z, x1.w)); \
      ra1 = make_uint4(pack2(y0.x, y0.y), pack2(y0.z, y0.w), pack2(y1.x, y1.y), pack2(y1.z, y1.w)); \
    } else {                                                                           \
      ra0 = *(const uint4*)((const u16*)Abase + (long)ar0 * lda + (k0) + lc * 8);      \
      ra1 = *(const uint4*)((const u16*)Abase + (long)ar1 * lda + (k0) + lc * 8);      \
    }                                                                                  \
    rb0 = *(const uint4*)(bp0 + (k0));                                                 \
    rb1 = *(const uint4*)(bp1 + (k0));                                                 \
  }
#define GEMM_STORE(buf)                                                 \
  {                                                                     \
    *(uint4*)(As + ((buf) * 128 + lr) * 32 + wsw) = ra0;             \
    *(uint4*)(As + ((buf) * 128 + lr + 64) * 32 + wsw) = ra1;        \
    *(uint4*)(Bs + ((buf) * 128 + lr) * 32 + wsw) = rb0;             \
    *(uint4*)(Bs + ((buf) * 128 + lr + 64) * 32 + wsw) = rb1;        \
  }
#pragma unroll
  for (int i = 0; i < 4; ++i)
#pragma unroll
    for (int j = 0; j < 4; ++j) acc[i][j] = f32x4{0.f, 0.f, 0.f, 0.f};
#define GEMM_COMPUTE(buf)                                                                                   \
  {                                                                                                         \
    bf16x8 af[4], bfr[4];                                                                                   \
    _Pragma("unroll") for (int i = 0; i < 4; ++i) {                                                         \
      af[i] = *(const bf16x8*)(As + ((buf) * 128 + 64 * wr + 16 * i + c) * 32 + rsw);                       \
      bfr[i] = *(const bf16x8*)(Bs + ((buf) * 128 + 64 * wc + 16 * i + c) * 32 + rsw);                      \
    }                                                                                                       \
    __builtin_amdgcn_s_setprio(1);                                                                          \
    _Pragma("unroll") for (int i = 0; i < 4; ++i)                                                           \
      _Pragma("unroll") for (int j = 0; j < 4; ++j)                                                         \
        acc[i][j] = SWAP ? MFMA(bfr[j], af[i], acc[i][j]) : MFMA(af[i], bfr[j], acc[i][j]);                 \
    __builtin_amdgcn_s_setprio(0);                                                                          \
    __builtin_amdgcn_sched_group_barrier(0x100, 8, 0);                                                      \
    __builtin_amdgcn_sched_group_barrier(0x008, 16, 0);                                                     \
  }
  const int nk = K >> 5;
  if (AF32) {
    GEMM_LOAD(0);
    GEMM_STORE(0);
    __syncthreads();
    for (int kt = 0; kt < nk; ++kt) {
      const int buf = kt & 1;
      GEMM_LOAD(min((kt + 1) * 32, K - 32));
      GEMM_COMPUTE(buf);
      GEMM_STORE(buf ^ 1);
      __syncthreads();
    }
  } else {
    uint4 sa0, sa1, sb0, sb1;
#define GEMM_LOAD2(k0)                                                              \
  {                                                                                 \
    sa0 = *(const uint4*)((const u16*)Abase + (long)ar0 * lda + (k0) + lc * 8);     \
    sa1 = *(const uint4*)((const u16*)Abase + (long)ar1 * lda + (k0) + lc * 8);     \
    sb0 = *(const uint4*)(bp0 + (k0));                                              \
    sb1 = *(const uint4*)(bp1 + (k0));                                              \
  }
#define GEMM_STORE2(buf)                                          \
  {                                                               \
    *(uint4*)(As + ((buf) * 128 + lr) * 32 + wsw) = sa0;          \
    *(uint4*)(As + ((buf) * 128 + lr + 64) * 32 + wsw) = sa1;     \
    *(uint4*)(Bs + ((buf) * 128 + lr) * 32 + wsw) = sb0;          \
    *(uint4*)(Bs + ((buf) * 128 + lr + 64) * 32 + wsw) = sb1;     \
  }
    const int klast = K - 32;
    GEMM_LOAD(0);
    GEMM_LOAD2(32);
    GEMM_STORE(0);
    __syncthreads();
    for (int kt = 0; kt < nk; kt += 2) {
      GEMM_LOAD(min((kt + 2) * 32, klast));
      GEMM_COMPUTE(0);
      GEMM_STORE2(1);
      __syncthreads();
      GEMM_LOAD2(min((kt + 3) * 32, klast));
      GEMM_COMPUTE(1);
      GEMM_STORE(0);
      __syncthreads();
    }
#undef GEMM_LOAD2
#undef GEMM_STORE2
  }
#undef GEMM_COMPUTE
#undef GEMM_LOAD
#undef GEMM_STORE
}

#define EPI_COORDS                                                             \
  const int tid = my_tid(), l = tid & 63, w = tid >> 6, c = l & 15, g = l >> 4; \
  const int wr = w >> 1, wc = w & 1;                                           \
  const int rbase = m0 + 64 * wr + 4 * g, cbase = n0 + 64 * wc + c;

template <bool SWAP = false>
DI void gemm_main8(const u16* Abase, long lda, const u16* Bt, long ldb, int K, f32x4 (&acc)[8][4], char* smem) {
  const int tid = my_tid(), l = tid & 63, w = tid >> 6, c = l & 15, g = l >> 4;
  const int wr = w >> 1, wc = w & 1;
  const int lr = tid >> 2, lc = tid & 3;
  u16* As = (u16*)smem;
  u16* Bs = As + 2 * 256 * 32;
  const int wsw = (lc ^ ((0 - (lr >> 2)) & 3)) * 8;
  const int rsw = (g ^ ((0 - (c >> 2)) & 3)) * 8;
  const u16* ap = Abase + (long)lr * lda + lc * 8;
  const u16* bp = Bt + (long)lr * ldb + lc * 8;
  uint4 xa0, xa1, xa2, xa3, xb0, xb1;
  uint4 ya0, ya1, ya2, ya3, yb0, yb1;
#define GEMM8_LOAD(S, k0)                                \
  {                                                      \
    S##a0 = *(const uint4*)(ap + (k0));                  \
    S##a1 = *(const uint4*)(ap + 64 * lda + (k0));       \
    S##a2 = *(const uint4*)(ap + 128 * lda + (k0));      \
    S##a3 = *(const uint4*)(ap + 192 * lda + (k0));      \
    S##b0 = *(const uint4*)(bp + (k0));                  \
    S##b1 = *(const uint4*)(bp + 64 * ldb + (k0));       \
  }
#define GEMM8_STORE(S, buf)                                              \
  {                                                                      \
    *(uint4*)(As + ((buf) * 256 + lr) * 32 + wsw) = S##a0;            \
    *(uint4*)(As + ((buf) * 256 + lr + 64) * 32 + wsw) = S##a1;       \
    *(uint4*)(As + ((buf) * 256 + lr + 128) * 32 + wsw) = S##a2;      \
    *(uint4*)(As + ((buf) * 256 + lr + 192) * 32 + wsw) = S##a3;      \
    *(uint4*)(Bs + ((buf) * 128 + lr) * 32 + wsw) = S##b0;            \
    *(uint4*)(Bs + ((buf) * 128 + lr + 64) * 32 + wsw) = S##b1;       \
  }
#define GEMM8_COMPUTE(buf)                                                                        \
  {                                                                                               \
    bf16x8 bfr[4], af[8];                                                                         \
    _Pragma("unroll") for (int i = 0; i < 4; ++i) bfr[i] =                                        \
        *(const bf16x8*)(Bs + ((buf) * 128 + 64 * wc + 16 * i + c) * 32 + rsw);                   \
    _Pragma("unroll") for (int i = 0; i < 8; ++i) af[i] =                                         \
        *(const bf16x8*)(As + ((buf) * 256 + 128 * wr + 16 * i + c) * 32 + rsw);                  \
    __builtin_amdgcn_s_setprio(1);                                                                \
    _Pragma("unroll") for (int i = 0; i < 8; ++i) {                                               \
      _Pragma("unroll") for (int j = 0; j < 4; ++j) acc[i][j] = SWAP ? MFMA(bfr[j], af[i], acc[i][j]) : MFMA(af[i], bfr[j], acc[i][j]); \
    }                                                                                             \
    __builtin_amdgcn_s_setprio(0);                                                                \
    __builtin_amdgcn_sched_group_barrier(0x100, 12, 0);                                           \
    __builtin_amdgcn_sched_group_barrier(0x008, 32, 0);                                           \
  }
#pragma unroll
  for (int i = 0; i < 8; ++i)
#pragma unroll
    for (int j = 0; j < 4; ++j) acc[i][j] = f32x4{0.f, 0.f, 0.f, 0.f};
  const int nk = K >> 5;
  GEMM8_LOAD(x, 0);
  GEMM8_LOAD(y, 32);
  GEMM8_STORE(x, 0);
  __syncthreads();
  const int klast = K - 32;
  for (int kt = 0; kt < nk; kt += 2) {
    GEMM8_LOAD(x, min((kt + 2) * 32, klast));
    GEMM8_COMPUTE(0);
    GEMM8_STORE(y, 1);
    __syncthreads();
    GEMM8_LOAD(y, min((kt + 3) * 32, klast));
    GEMM8_COMPUTE(1);
    GEMM8_STORE(x, 0);
    __syncthreads();
  }
#undef GEMM8_COMPUTE
#undef GEMM8_LOAD
#undef GEMM8_STORE
}

#define EPI_COORDS8                                                            \
  const int tid = my_tid(), l = tid & 63, w = tid >> 6, c = l & 15, g = l >> 4; \
  const int wr = w >> 1, wc = w & 1;                                           \
  const int rbase = m0 + 128 * wr + 4 * g, cbase = n0 + 64 * wc + c;

#define EPI_COORDS_S(WM)                                                       \
  const int tid = my_tid(), l = tid & 63, w = tid >> 6, c = l & 15, g = l >> 4; \
  const int wr = w >> 1, wc = w & 1;                                           \
  const int rrow = m0 + (WM) * wr + c, ccol = n0 + 64 * wc + 4 * g;

DI float rs_from_ssq(const float* ssq, long m) { return rsqrtf(ssq[m] * (1.f / 1024.f) + 1e-6f); }

DI void decode_xcd(int tile, int NT, int& mt, int& nt) {
  const int xcd = tile & 7, j = tile >> 3;
  mt = (j / NT) * 8 + xcd;
  nt = j % NT;
}

DI void decode_xcd2d(int tile, int NT, int& mt, int& nt) {
  const int xcd = tile & 7, j = tile >> 3, hn = NT >> 1;
  mt = (j / hn) * 4 + (xcd >> 1);
  nt = (xcd & 1) * hn + j % hn;
}

DI float lg_head(int h) { return log1pf(-exp2f(-5.f - (float)h)); }

DI void ret_qkv_tile(const Params& p, int tile, char* smem) {
  int mt, nt;
  decode_xcd2d(tile, 32, mt, nt);
  const int m0 = mt * 256, n0 = nt * 128;
  f32x4 acc[8][4];
  gemm_main8((const u16*)(p.ws + OFF_XB) + (long)m0 * 1024, 1024, wsW(p) + W_RET_IN + (long)n0 * 1024, 1024, 1024, acc, smem);
  EPI_COORDS8
  const float* rs = (const float*)(p.ws + OFF_RS);
  if (n0 < 2048) {
    const int part = n0 >> 10, head = (n0 & 1023) >> 8;
    const int dpb = (n0 & 255) + 64 * wc;
    const float lgh = lg_head(head);
    u16* Q = (u16*)(p.ws + OFF_Q);
    u16* Kb = (u16*)(p.ws + OFF_K);
    u16* Ktd = (u16*)(p.ws + OFF_KTD);
#pragma unroll
    for (int a = 0; a < 2; ++a) {
      const int dp1 = dpb + 32 * a + c, dp2 = dp1 + 16;
      const int i = ((dpb + 32 * a) >> 1) + c;
      const float ir = exp2f(-(float)i * (13.287712379549449f / 128.0f)) * 0.15915494309189535f;
#pragma unroll
      for (int ti = 0; ti < 8; ++ti) {
        float y1[4], y2[4];
        const int mrow0 = rbase + 16 * ti;
        const int b = mrow0 >> 14;
        const int t0 = mrow0 & (T - 1);
#pragma unroll
        for (int j = 0; j < 4; ++j) {
          const int t = t0 + j;
          const float r = rs[mrow0 + j];
          const float x1 = acc[ti][2 * a][j] * r, x2 = acc[ti][2 * a + 1][j] * r;
          const float tf = (float)t;
          const float pr_ = tf * ir;
          const float er_ = fmaf(tf, ir, -pr_);
          const float rf = (pr_ - floorf(pr_)) + er_;
          const float sn = __builtin_amdgcn_sinf(rf), cs = __builtin_amdgcn_cosf(rf);
          y1[j] = x1 * cs - x2 * sn;
          y2[j] = x1 * sn + x2 * cs;
        }
        const long bh = (long)b * 4 + head;
        if (part == 0) {
#pragma unroll
          for (int j = 0; j < 4; ++j) {
            Q[(bh * T + t0 + j) * 256 + dp1] = f2bf(y1[j]);
            Q[(bh * T + t0 + j) * 256 + dp2] = f2bf(y2[j]);
          }
        } else {
          float kd[4];
#pragma unroll
          for (int j = 0; j < 4; ++j) {
            y1[j] *= 0.0625f;
            y2[j] *= 0.0625f;
            Kb[(bh * T + t0 + j) * 256 + dp1] = f2bf(y1[j]);
            Kb[(bh * T + t0 + j) * 256 + dp2] = f2bf(y2[j]);
            kd[j] = __expf((float)(127 - ((t0 + j) & 127)) * lgh);
          }
          *(uint2*)(Ktd + ((bh * 128 + (t0 >> 7)) * 256 + dp1) * 128 + (t0 & 127)) = pack4h(y1[0] * kd[0], y1[1] * kd[1], y1[2] * kd[2], y1[3] * kd[3]);
          *(uint2*)(Ktd + ((bh * 128 + (t0 >> 7)) * 256 + dp2) * 128 + (t0 & 127)) = pack4h(y2[0] * kd[0], y2[1] * kd[1], y2[2] * kd[2], y2[3] * kd[3]);
        }
        __builtin_amdgcn_sched_barrier(0);
      }
    }
  } else {
    u16* Vt = (u16*)(p.ws + OFF_VT);
#pragma unroll
    for (int ti = 0; ti < 8; ++ti) {
      const int mrow0 = rbase + 16 * ti;
      const int b = mrow0 >> 14, t0 = mrow0 & (T - 1);
      const float r0 = rs[mrow0], r1 = rs[mrow0 + 1], r2 = rs[mrow0 + 2], r3 = rs[mrow0 + 3];
#pragma unroll
      for (int tj = 0; tj < 4; ++tj) {
        const int nv = cbase + 16 * tj - 2048;
        const int head = nv >> 9, dv = nv & 511;
        *(uint2*)(Vt + ((((long)b * 4 + head) * 128 + (t0 >> 7)) * 512 + dv) * 128 + (t0 & 127)) =
            pack4h(acc[ti][tj][0] * r0, acc[ti][tj][1] * r1, acc[ti][tj][2] * r2, acc[ti][tj][3] * r3);
      }
    }
  }
}

DI void ret_p_tile(const Params& p, int z, char* smem) {
  const int bh = z >> 7, head = bh & 3;
  const u16* Q = (const u16*)(p.ws + OFF_Q) + (long)z * 128 * 256;
  const u16* Kb = (const u16*)(p.ws + OFF_K) + (long)z * 128 * 256;
  f32x4 acc[4][4];
  gemm_main<false, true>(Q, 256, 128, Kb, 256, 256, acc, smem);
  const int m0 = 0, n0 = 0;
  EPI_COORDS_S(64)
  const float lgh = lg_head(head);
  u16* P = (u16*)(p.ws + OFF_P) + (long)z * 128 * 128;
#pragma unroll
  for (int ti = 0; ti < 4; ++ti) {
    const int n = rrow + 16 * ti;
#pragma unroll
    for (int tj = 0; tj < 4; ++tj) {
      const int mb = ccol + 16 * tj;
      float v[4];
#pragma unroll
      for (int jj = 0; jj < 4; ++jj) v[jj] = (n >= mb + jj) ? acc[ti][tj][jj] * __expf((float)(n - mb - jj) * lgh) : 0.f;
      *(uint2*)(P + n * 128 + mb) = pack4h(v[0], v[1], v[2], v[3]);
    }
  }
}

DI void ret_scan_item(const Params& p, int item, char* smem) {
  const int tid = my_tid(), l = tid & 63, w = tid >> 6, c = l & 15, g = l >> 4;
  const int bh = item & 7, sl = item >> 3;
  const int b = bh >> 2, head = bh & 3;
  const int dv0 = sl * 16;
  const float lgh = lg_head(head);
  const float cdec = __expf(128.f * lgh);
  u16* S = (u16*)smem;
  for (int i = tid; i < 16 * 264; i += 256) S[i] = 0;
  __syncthreads();
  const u16* Q = (const u16*)(p.ws + OFF_Q) + (long)bh * T * 256;
  const u16* Ktd = (const u16*)(p.ws + OFF_KTD) + (long)bh * 256 * T;
  const u16* Vt = (const u16*)(p.ws + OFF_VT) + (long)bh * 512 * T + (long)(dv0 + c) * 128;
  const u16* P = (const u16*)(p.ws + OFF_P) + (long)bh * 128 * 128 * 128;
  u16* O = (u16*)p.out;
  f32x4 st[4];
#pragma unroll
  for (int i = 0; i < 4; ++i) st[i] = f32x4{0.f, 0.f, 0.f, 0.f};
  float qd[2][4];
#pragma unroll
  for (int r2 = 0; r2 < 2; ++r2)
#pragma unroll
    for (int j = 0; j < 4; ++j) qd[r2][j] = __expf((float)(32 * w + 16 * r2 + 4 * g + j + 1) * lgh);
  bf16x8 vb[4], pf[2][4], qa[2][8], kf[4][4];
#define SCAN_LOAD(chn)                                                                                          \
  {                                                                                                             \
    const int tn_ = (chn) * 128;                                                                                \
    _Pragma("unroll") for (int ks = 0; ks < 4; ++ks) vb[ks] = *(const bf16x8*)(Vt + (long)(chn) * 65536 + 32 * ks + 8 * g);     \
    _Pragma("unroll") for (int r2 = 0; r2 < 2; ++r2) {                                                          \
      const u16* pr_ = P + ((long)(chn) * 128 + 32 * w + 16 * r2 + c) * 128 + 8 * g;                            \
      _Pragma("unroll") for (int ks = 0; ks < 4; ++ks) pf[r2][ks] = *(const bf16x8*)(pr_ + 32 * ks);            \
      const u16* qr_ = Q + (long)(tn_ + 32 * w + 16 * r2 + c) * 256 + 8 * g;                                    \
      _Pragma("unroll") for (int k8 = 0; k8 < 8; ++k8) qa[r2][k8] = *(const bf16x8*)(qr_ + 32 * k8);            \
    }                                                                                                           \
    _Pragma("unroll") for (int rt = 0; rt < 4; ++rt) {                                                          \
      const u16* kr_ = Ktd + (long)(chn) * 32768 + (64 * w + 16 * rt + c) * 128 + 8 * g;                                    \
      _Pragma("unroll") for (int ks = 0; ks < 4; ++ks) kf[rt][ks] = *(const bf16x8*)(kr_ + 32 * ks);            \
    }                                                                                                           \
  }
  SCAN_LOAD(0);
  for (int ch = 0; ch < 128; ++ch) {
    const int t0 = ch * 128;
    f32x4 apv[2], aqs[2];
#pragma unroll
    for (int r2 = 0; r2 < 2; ++r2) {
      apv[r2] = f32x4{0.f, 0.f, 0.f, 0.f};
      aqs[r2] = f32x4{0.f, 0.f, 0.f, 0.f};
#pragma unroll
      for (int ks = 0; ks < 4; ++ks) apv[r2] = MFMA(pf[r2][ks], vb[ks], apv[r2]);
    }
#pragma unroll
    for (int k8 = 0; k8 < 8; ++k8) {
      const bf16x8 sb = *(const bf16x8*)(S + c * 264 + 32 * k8 + 8 * g);
#pragma unroll
      for (int r2 = 0; r2 < 2; ++r2) aqs[r2] = MFMA(qa[r2][k8], sb, aqs[r2]);
    }
#pragma unroll
    for (int rt = 0; rt < 4; ++rt) {
      st[rt] *= cdec;
#pragma unroll
      for (int ks = 0; ks < 4; ++ks) st[rt] = MFMA(kf[rt][ks], vb[ks], st[rt]);
    }
    __builtin_amdgcn_sched_barrier(0);
    SCAN_LOAD(min(ch + 1, 127));
    __builtin_amdgcn_sched_barrier(0);
#pragma unroll
    for (int r2 = 0; r2 < 2; ++r2)
#pragma unroll
      for (int j = 0; j < 4; ++j) {
        const int n = 32 * w + 16 * r2 + 4 * g + j;
        const float v = apv[r2][j] + qd[r2][j] * aqs[r2][j];
        O[((long)b * T + t0 + n) * 2048 + head * 512 + dv0 + c] = f2bf(v);
      }
    lds_barrier();
#pragma unroll
    for (int rt = 0; rt < 4; ++rt)
      *(uint2*)(S + c * 264 + 64 * w + 16 * rt + 4 * g) = pack4(st[rt][0], st[rt][1], st[rt][2], st[rt][3]);
    lds_barrier();
  }
#undef SCAN_LOAD
}

DI void ret_gate_tile(const Params& p, int tile, char* smem) {
  int mt, nt;
  decode_xcd(tile, 16, mt, nt);
  const int m0 = mt * 256, n0 = nt * 128;
  f32x4 acc[8][4];
  gemm_main8<true>((const u16*)(p.ws + OFF_XB) + (long)m0 * 1024, 1024, wsW(p) + W_RET_IN + (long)(4096 + n0) * 1024, 1024, 1024, acc, smem);
  EPI_COORDS_S(128)
  const float* rs = (const float*)(p.ws + OFF_RS);
  const float* stats = (const float*)(p.ws + OFF_STATS);
  const u16* O = (const u16*)p.out;
  u16* A2 = (u16*)(p.ws + OFF_A2);
  const int head = n0 >> 9;
  float4 gn[4];
#pragma unroll
  for (int tj = 0; tj < 4; ++tj) gn[tj] = *(const float4*)(p.ret_gn + ccol + 16 * tj);
#pragma unroll
  for (int hh = 0; hh < 2; ++hh) {
    float r[4];
    float2 st[4];
    uint2 ov[4][4];
#pragma unroll
    for (int t4 = 0; t4 < 4; ++t4) {
      const long m = rrow + 16 * (4 * hh + t4);
      r[t4] = rs[m];
      st[t4] = *(const float2*)(stats + (m * 4 + head) * 2);
#pragma unroll
      for (int tj = 0; tj < 4; ++tj) ov[t4][tj] = *(const uint2*)(O + m * 2048 + ccol + 16 * tj);
    }
    __builtin_amdgcn_sched_barrier(0);
#pragma unroll
    for (int t4 = 0; t4 < 4; ++t4) {
      const int ti = 4 * hh + t4;
      const long m = rrow + 16 * ti;
      const float mu = st[t4].x, rstd = st[t4].y;
#pragma unroll
      for (int tj = 0; tj < 4; ++tj) {
        const uint2 o = ov[t4][tj];
        const float o0 = __uint_as_float(o.x << 16), o1 = __uint_as_float(o.x & 0xffff0000u);
        const float o2 = __uint_as_float(o.y << 16), o3 = __uint_as_float(o.y & 0xffff0000u);
        const float g0 = acc[ti][tj][0] * r[t4], g1 = acc[ti][tj][1] * r[t4], g2 = acc[ti][tj][2] * r[t4], g3 = acc[ti][tj][3] * r[t4];
        *(uint2*)(A2 + m * 2048 + ccol + 16 * tj) =
            pack4h(g0 * sigmoidf_(g0) * (o0 - mu) * rstd * gn[tj].x, g1 * sigmoidf_(g1) * (o1 - mu) * rstd * gn[tj].y,
                  g2 * sigmoidf_(g2) * (o2 - mu) * rstd * gn[tj].z, g3 * sigmoidf_(g3) * (o3 - mu) * rstd * gn[tj].w);
      }
    }
    __builtin_amdgcn_sched_barrier(0);
  }
}

DI void ret_out_tile(const Params& p, int tile, char* smem) {
  int mt, nt;
  decode_xcd(tile, 8, mt, nt);
  const int m0 = mt * 256, n0 = nt * 128;
  f32x4 acc[8][4];
  gemm_main8<true>((const u16*)(p.ws + OFF_A2) + (long)m0 * 2048, 2048, wsW(p) + W_RET_OUT + (long)n0 * 2048, 2048, 2048, acc, smem);
  EPI_COORDS_S(128)
#pragma unroll
  for (int hh = 0; hh < 2; ++hh) {
    float4 xv[4][4];
#pragma unroll
    for (int t4 = 0; t4 < 4; ++t4)
#pragma unroll
      for (int tj = 0; tj < 4; ++tj) xv[t4][tj] = ld_nt4(p.x + (long)(rrow + 16 * (4 * hh + t4)) * 1024 + ccol + 16 * tj);
    __builtin_amdgcn_sched_barrier(0);
#pragma unroll
    for (int t4 = 0; t4 < 4; ++t4) {
      const int ti = 4 * hh + t4;
      const long m = rrow + 16 * ti;
      float ss = 0.f;
#pragma unroll
      for (int tj = 0; tj < 4; ++tj) {
        const int n = ccol + 16 * tj;
        const float4 h = make_float4(xv[t4][tj].x + acc[ti][tj][0], xv[t4][tj].y + acc[ti][tj][1], xv[t4][tj].z + acc[ti][tj][2],
                                     xv[t4][tj].w + acc[ti][tj][3]);
        *(float4*)(p.out + m * 1024 + n) = h;
        *(uint2*)((u16*)(p.ws + OFF_XB) + m * 1024 + n) = pack4h(h.x, h.y, h.z, h.w);
        ss += h.x * h.x + h.y * h.y + h.z * h.z + h.w * h.w;
      }
      ss = xsum16(xsum32(ss));
      if (g == 0) atomicAdd((float*)(p.ws + OFF_SSQ1) + m, ss);
    }
    __builtin_amdgcn_sched_barrier(0);
  }
}

DI void ple_tile(const Params& p, int layer, int tile, char* smem) {
  int mt, nt;
  decode_xcd(tile, 8, mt, nt);
  const int m0 = mt * 128, n0 = nt * 128;
  f32x4 ae[4][4], ag[4][4];
  gemm_main<true, true>(p.p + ((long)layer * M + m0) * 256, 256, 128, wsW(p) + W_PE + (long)layer * 1024 * 256 + (long)n0 * 256, 256, 256, ae, smem);
  gemm_main<false, true>((const u16*)(p.ws + OFF_XB) + (long)m0 * 1024, 1024, 128, wsW(p) + W_PG + (long)layer * 1024 * 1024 + (long)n0 * 1024, 1024, 1024, ag, smem);
  EPI_COORDS_S(64)
  const float* ssq_in = (const float*)(p.ws + (layer == 0 ? OFF_SSQ1 : OFF_SSQ3));
  float rq[4];
  float4 hv[4][4];
#pragma unroll
  for (int ti = 0; ti < 4; ++ti) {
    rq[ti] = ssq_in[rrow + 16 * ti];
#pragma unroll
    for (int tj = 0; tj < 4; ++tj) hv[ti][tj] = *(const float4*)(p.out + (long)(rrow + 16 * ti) * 1024 + ccol + 16 * tj);
  }
  __builtin_amdgcn_sched_barrier(0);
#pragma unroll
  for (int ti = 0; ti < 4; ++ti) {
    const long m = rrow + 16 * ti;
    const float r = rsqrtf(rq[ti] * (1.f / 1024.f) + 1e-6f);
    float ss = 0.f;
#pragma unroll
    for (int tj = 0; tj < 4; ++tj) {
      float4 h = hv[ti][tj];
      h.x += sigmoidf_(ag[ti][tj][0] * r) * ae[ti][tj][0];
      h.y += sigmoidf_(ag[ti][tj][1] * r) * ae[ti][tj][1];
      h.z += sigmoidf_(ag[ti][tj][2] * r) * ae[ti][tj][2];
      h.w += sigmoidf_(ag[ti][tj][3] * r) * ae[ti][tj][3];
      *(float4*)(p.out + m * 1024 + ccol + 16 * tj) = h;
      if (layer == 0) {
        *(uint2*)((u16*)(p.ws + OFF_XB2) + m * 1024 + ccol + 16 * tj) = pack4(h.x, h.y, h.z, h.w);
        ss += h.x * h.x + h.y * h.y + h.z * h.z + h.w * h.w;
      }
    }
    if (layer == 0) {
      ss = xsum16(xsum32(ss));
      if (g == 0) atomicAdd((float*)(p.ws + OFF_SSQ2) + m, ss);
    }
  }
}

DI u16* kvpart(const Params& p, int part) { return (u16*)(p.ws + OFF_KV + (long)part * 32 * MiB); }

DI void kv_tile(const Params& p, int tile, char* smem) {
  int mt, nt;
  decode_xcd2d(tile, 24, mt, nt);
  const int m0 = mt * 256, n0 = nt * 128;
  const float* ssq = (const float*)(p.ws + OFF_SSQ2);
  const int part = nt >> 2, grp = nt & 3;
  u16* dst = kvpart(p, part);
  const bool transposed = (part == 3) || (part == 5);
  f32x4 acc[8][4];
  if (transposed) {
    gemm_main8<false>((const u16*)(p.ws + OFF_XB2) + (long)m0 * 1024, 1024, wsW(p) + W_KV + (long)n0 * 1024, 1024, 1024, acc, smem);
    EPI_COORDS8
#pragma unroll
    for (int ti = 0; ti < 8; ++ti) {
      const int mrow0 = rbase + 16 * ti;
      const int b = mrow0 >> 14, t0 = mrow0 & (T - 1);
      const long bg = (long)b * 4 + grp;
      const float r0 = rs_from_ssq(ssq, mrow0), r1 = rs_from_ssq(ssq, mrow0 + 1), r2 = rs_from_ssq(ssq, mrow0 + 2), r3 = rs_from_ssq(ssq, mrow0 + 3);
#pragma unroll
      for (int tj = 0; tj < 4; ++tj) {
        const int d = 64 * wc + 16 * tj + c;
        *(uint2*)(dst + ((bg * 256 + (t0 >> 6)) * 128 + d) * 64 + (t0 & 63)) =
            pack4h(acc[ti][tj][0] * r0, acc[ti][tj][1] * r1, acc[ti][tj][2] * r2, acc[ti][tj][3] * r3);
      }
    }
  } else {
    gemm_main8<true>((const u16*)(p.ws + OFF_XB2) + (long)m0 * 1024, 1024, wsW(p) + W_KV + (long)n0 * 1024, 1024, 1024, acc, smem);
    EPI_COORDS_S(128)
#pragma unroll
    for (int ti = 0; ti < 8; ++ti) {
      const int m = rrow + 16 * ti;
      const int b = m >> 14, t = m & (T - 1);
      const float r = rs_from_ssq(ssq, m);
      u16* q = dst + (((long)b * 4 + grp) * T + t) * 128 + 64 * wc + 4 * g;
#pragma unroll
      for (int tj = 0; tj < 4; ++tj)
        *(uint2*)(q + 16 * tj) = pack4h(acc[ti][tj][0] * r, acc[ti][tj][1] * r, acc[ti][tj][2] * r, acc[ti][tj][3] * r);
    }
  }
}

DI void nsaq_tile(const Params& p, int tile, char* smem) {
  int mt, nt;
  decode_xcd(tile, 17, mt, nt);
  const int m0 = mt * 256, n0 = nt * 128;
  f32x4 acc[8][4];
  gemm_main8<true>((const u16*)(p.ws + OFF_XB2) + (long)m0 * 1024, 1024, wsW(p) + W_NSA + (long)n0 * 1024, 1024, 1024, acc, smem);
  EPI_COORDS_S(128)
  const float* ssq = (const float*)(p.ws + OFF_SSQ2);
  u16* Qn = (u16*)(p.ws + OFF_QN);
  float* gates = (float*)(p.ws + OFF_GATES);
  const float qscale = 0.08838834764831845f * 1.4426950408889634f;
#pragma unroll
  for (int ti = 0; ti < 8; ++ti) {
    const long m = rrow + 16 * ti;
    const float r = rs_from_ssq(ssq, m);
#pragma unroll
    for (int tj = 0; tj < 4; ++tj) {
      const int n = ccol + 16 * tj;
      const float v0 = acc[ti][tj][0] * r, v1 = acc[ti][tj][1] * r, v2 = acc[ti][tj][2] * r, v3 = acc[ti][tj][3] * r;
      if (n < 2048) *(uint2*)(Qn + m * 2048 + n) = pack4h(v0 * qscale, v1 * qscale, v2 * qscale, v3 * qscale);
      else if (n < 2096) *(float4*)(gates + m * 48 + (n - 2048)) = make_float4(sigmoidf_(v0), sigmoidf_(v1), sigmoidf_(v2), sigmoidf_(v3));
    }
  }
}

DI float gelu_tanh(float x) {
  const float u = 0.7978845608028654f * (x + 0.044715f * x * x * x);
  return 0.5f * x * (1.f + tanhf(u));
}

DI void cmp1_tile(const Params& p, int tile, char* smem) {
  const int z = tile >> 4, mt = (tile >> 1) & 7, nt = tile & 1;
  const int kind = z >> 3, bg = z & 7;
  const int m0 = mt * 128, n0 = nt * 128;
  const u16* A = kvpart(p, kind) + (long)bg * T * 128 + (long)m0 * 2048;
  f32x4 acc[4][4];
  gemm_main<false>(A, 2048, 1023 - m0, wsW(p) + (kind ? W_C1V : W_C1K) + (long)n0 * 4096, 4096, 4096, acc, smem);
  EPI_COORDS
  const float* bpart = (const float*)(p.ws + OFF_BIAS) + kind * 32 * 256;
  u16* H = (u16*)(p.ws + OFF_H) + (long)z * 1024 * 256;
  float bias[4];
#pragma unroll
  for (int tj = 0; tj < 4; ++tj) {
    float bs = 0.f;
    for (int q = 0; q < 32; ++q) bs += bpart[q * 256 + cbase + 16 * tj];
    bias[tj] = bs;
  }
#pragma unroll
  for (int ti = 0; ti < 4; ++ti)
#pragma unroll
    for (int j = 0; j < 4; ++j) {
      const int m = rbase + 16 * ti + j;
#pragma unroll
      for (int tj = 0; tj < 4; ++tj) {
        const int n = cbase + 16 * tj;
        const float v = (m < 1023) ? gelu_tanh(acc[ti][tj][j] + bias[tj]) : 0.f;
        H[(long)m * 256 + n] = f2bf(v);
      }
    }
}

DI void cmp2_tile(const Params& p, int tile, char* smem) {
  const int z = tile >> 3, mt = tile & 7;
  const int kind = z >> 3, bg = z & 7;
  const int m0 = mt * 128, n0 = 0;
  const u16* A = (const u16*)(p.ws + OFF_H) + (long)z * 1024 * 256 + (long)m0 * 256;
  f32x4 acc[4][4];
  gemm_main<false>(A, 256, 128, wsW(p) + (kind ? W_C2V : W_C2K), 256, 256, acc, smem);
  EPI_COORDS
  if (kind == 0) {
    u16* Kc = (u16*)(p.ws + OFF_KCMP) + (long)bg * 1024 * 128;
#pragma unroll
    for (int ti = 0; ti < 4; ++ti)
#pragma unroll
      for (int j = 0; j < 4; ++j) {
        const int m = rbase + 16 * ti + j;
#pragma unroll
        for (int tj = 0; tj < 4; ++tj) Kc[(long)m * 128 + cbase + 16 * tj] = f2bf(m < 1023 ? acc[ti][tj][j] : 0.f);
      }
  } else {
    u16* Vc = (u16*)(p.ws + OFF_VCMPT) + (long)bg * 128 * 1024;
#pragma unroll
    for (int ti = 0; ti < 4; ++ti) {
      const int mrow0 = rbase + 16 * ti;
#pragma unroll
      for (int tj = 0; tj < 4; ++tj) {
        const int n = cbase + 16 * tj;
        const float v3 = (mrow0 + 3 < 1023) ? acc[ti][tj][3] : 0.f;
        *(uint2*)(Vc + ((long)(mrow0 >> 6) * 128 + n) * 64 + (mrow0 & 63)) = pack4(acc[ti][tj][0], acc[ti][tj][1], acc[ti][tj][2], v3);
      }
    }
  }
}

DI void nsa_gate_tile(const Params& p, int tile, char* smem) {
  int mt, nt;
  decode_xcd(tile, 16, mt, nt);
  const int m0 = mt * 256, n0 = nt * 128;
  f32x4 acc[8][4];
  gemm_main8<true>((const u16*)(p.ws + OFF_XB2) + (long)m0 * 1024, 1024, wsW(p) + W_NSA + (long)(2176 + n0) * 1024, 1024, 1024, acc, smem);
  EPI_COORDS_S(128)
  const float* ssq = (const float*)(p.ws + OFF_SSQ2);
  u16* O = (u16*)(p.ws + OFF_QN);
#pragma unroll
  for (int hh = 0; hh < 2; ++hh) {
    float r[4];
    uint2 ov[4][4];
#pragma unroll
    for (int t4 = 0; t4 < 4; ++t4) {
      const long m = rrow + 16 * (4 * hh + t4);
      r[t4] = ssq[m];
#pragma unroll
      for (int tj = 0; tj < 4; ++tj) ov[t4][tj] = *(const uint2*)(O + m * 2048 + ccol + 16 * tj);
    }
    __builtin_amdgcn_sched_barrier(0);
#pragma unroll
    for (int t4 = 0; t4 < 4; ++t4) {
      const int ti = 4 * hh + t4;
      const long m = rrow + 16 * ti;
      const float rr = rsqrtf(r[t4] * (1.f / 1024.f) + 1e-6f);
#pragma unroll
      for (int tj = 0; tj < 4; ++tj) {
        const uint2 o = ov[t4][tj];
        const float o0 = __uint_as_float(o.x << 16), o1 = __uint_as_float(o.x & 0xffff0000u);
        const float o2 = __uint_as_float(o.y << 16), o3 = __uint_as_float(o.y & 0xffff0000u);
        const float g0 = acc[ti][tj][0] * rr, g1 = acc[ti][tj][1] * rr, g2 = acc[ti][tj][2] * rr, g3 = acc[ti][tj][3] * rr;
        *(uint2*)(O + m * 2048 + ccol + 16 * tj) = pack4h(g0 * sigmoidf_(g0) * o0, g1 * sigmoidf_(g1) * o1, g2 * sigmoidf_(g2) * o2, g3 * sigmoidf_(g3) * o3);
      }
    }
    __builtin_amdgcn_sched_barrier(0);
  }
}

DI void nsa_out_tile(const Params& p, int tile, char* smem) {
  int mt, nt;
  decode_xcd(tile, 8, mt, nt);
  const int m0 = mt * 256, n0 = nt * 128;
  f32x4 acc[8][4];
  gemm_main8<true>((const u16*)(p.ws + OFF_QN) + (long)m0 * 2048, 2048, wsW(p) + W_NSA_OUT + (long)n0 * 2048, 2048, 2048, acc, smem);
  EPI_COORDS_S(128)
#pragma unroll
  for (int hh = 0; hh < 2; ++hh) {
    float4 hv[4][4];
#pragma unroll
    for (int t4 = 0; t4 < 4; ++t4)
#pragma unroll
      for (int tj = 0; tj < 4; ++tj) hv[t4][tj] = *(const float4*)(p.out + (long)(rrow + 16 * (4 * hh + t4)) * 1024 + ccol + 16 * tj);
    __builtin_amdgcn_sched_barrier(0);
#pragma unroll
    for (int t4 = 0; t4 < 4; ++t4) {
      const int ti = 4 * hh + t4;
      const long m = rrow + 16 * ti;
      float ss = 0.f;
#pragma unroll
      for (int tj = 0; tj < 4; ++tj) {
        float4 h = hv[t4][tj];
        h.x += acc[ti][tj][0]; h.y += acc[ti][tj][1]; h.z += acc[ti][tj][2]; h.w += acc[ti][tj][3];
        *(float4*)(p.out + m * 1024 + ccol + 16 * tj) = h;
        *(uint2*)((u16*)(p.ws + OFF_XB) + m * 1024 + ccol + 16 * tj) = pack4h(h.x, h.y, h.z, h.w);
        ss += h.x * h.x + h.y * h.y + h.z * h.z + h.w * h.w;
      }
      ss = xsum16(xsum32(ss));
      if (g == 0) atomicAdd((float*)(p.ws + OFF_SSQ3) + m, ss);
    }
    __builtin_amdgcn_sched_barrier(0);
  }
}

DI void wave_lds_fence() {
  __builtin_amdgcn_wave_barrier();
  asm volatile("s_waitcnt lgkmcnt(0)" ::: "memory");
  __builtin_amdgcn_wave_barrier();
}

DI bf16x8 pack8_mfma(float a0, float a1, float a2, float a3, float a4, float a5, float a6, float a7) {
  u32 p0, p1, p2, p3;
  asm volatile("v_cvt_pk_bf16_f32 %0, %4, %5\n\tv_cvt_pk_bf16_f32 %1, %6, %7\n\tv_cvt_pk_bf16_f32 %2, %8, %9\n\tv_cvt_pk_bf16_f32 %3, %10, %11\n\ts_nop 1"
               : "=&v"(p0), "=&v"(p1), "=&v"(p2), "=&v"(p3)
               : "v"(a0), "v"(a1), "v"(a2), "v"(a3), "v"(a4), "v"(a5), "v"(a6), "v"(a7));
  return __builtin_bit_cast(bf16x8, make_uint4(p0, p1, p2, p3));
}

constexpr int NSA_IMP_OFF = 32768;
constexpr int NSA_IMP_WAVE = 8 * 260 * 4;
constexpr int NSA_MASK_OFF = NSA_IMP_OFF + 4 * NSA_IMP_WAVE;
constexpr int SMEM_BYTES = NSA_MASK_OFF + 1024;

enum { NSA_SEL = 0, NSA_WIN = 1, NSA_CMP1 = 2, NSA_CMP2 = 3 };

template <int MODE, int u>
DI void nsa_block_compute(const char* stage, u32 m8, int j, const bf16x8 (&qf)[4], f32x4 (&O)[8], float& mrun, float& lrun, int tbase,
                          float invl, float& carry_in, float* imp, int l, int w, int c, int g) {
  const u32 mu = (m8 >> (4 * u)) & 0xfu;
  if (!mu) return;
  const int t = tbase + 8 * w + 4 * u + (c >> 2);
  const bool colok = (mu >> (c >> 2)) & 1u;
  int hi, lo;
  if (MODE == NSA_SEL) { hi = t; lo = -1; }
  else if (MODE == NSA_WIN) { hi = t; lo = t - 512; }
  else { hi = max(0, (t - 15) >> 4) - 1; lo = -1; }
  if (!colok) { hi = -1; lo = 0; }
  f32x4 s[4];
#pragma unroll
  for (int half = 0; half < 2; ++half) {
    const int r0 = 32 * half + 8 * (c >> 2) + (c & 3);
    s[2 * half] = f32x4{0.f, 0.f, 0.f, 0.f};
    s[2 * half + 1] = f32x4{0.f, 0.f, 0.f, 0.f};
    bf16x8 ka[8];
#pragma unroll
    for (int ds = 0; ds < 4; ++ds) {
      ka[2 * ds] = *(const bf16x8*)(stage + (r0 * 16 + ((4 * ds + g) ^ c)) * 16);
      ka[2 * ds + 1] = *(const bf16x8*)(stage + ((r0 + 4) * 16 + ((4 * ds + g) ^ c)) * 16);
    }
#pragma unroll
    for (int ds = 0; ds < 4; ++ds) {
      s[2 * half] = MFMA(ka[2 * ds], qf[ds], s[2 * half]);
      s[2 * half + 1] = MFMA(ka[2 * ds + 1], qf[ds], s[2 * half + 1]);
    }
    __builtin_amdgcn_sched_group_barrier(0x100, 8, 0);
    __builtin_amdgcn_sched_group_barrier(0x008, 8, 0);
    __builtin_amdgcn_sched_barrier(0);
  }
  float v[16];
  bool ok[16];
  const int tmin = tbase + 8 * w + 4 * u, tmax = tmin + 3;
  bool interior;
  if (MODE == NSA_SEL) interior = (j * 64 + 63 <= tmin);
  else if (MODE == NSA_WIN) interior = (j * 64 + 63 <= tmin) && (j * 64 > tmax - 512);
  else interior = (j * 64 + 63 <= max(0, (tmin - 15) >> 4) - 1);
  if (interior) {
#pragma unroll
    for (int q = 0; q < 4; ++q)
#pragma unroll
      for (int jj = 0; jj < 4; ++jj) {
        ok[4 * q + jj] = colok;
        v[4 * q + jj] = s[q][jj];
      }
  } else {
#pragma unroll
    for (int q = 0; q < 4; ++q)
#pragma unroll
      for (int jj = 0; jj < 4; ++jj) {
        const int key = j * 64 + 32 * (q >> 1) + 8 * g + 4 * (q & 1) + jj;
        ok[4 * q + jj] = (key > lo) && (key <= hi);
        v[4 * q + jj] = ok[4 * q + jj] ? s[q][jj] : -1e30f;
      }
  }
  if (MODE == NSA_CMP2) {
#pragma unroll
    for (int i = 0; i < 16; ++i) {
      float pr = ok[i] ? __builtin_amdgcn_exp2f(v[i] - mrun) * invl : 0.f;
      pr += dpp_xor1(pr);
      pr += dpp_xor2(pr);
      v[i] = pr;
    }
#pragma unroll
    for (int half = 0; half < 2; ++half) {
      const float* pr = v + 8 * half;
      const float up = __shfl_up(pr[7], 16);
      const float last = __shfl(pr[7], 48 + c);
      const float cin = (g == 0) ? carry_in : up;
      carry_in = last;
      if ((c & 3) == 0) {
        const int bj = 16 * j + 8 * half + 2 * g;
        float* row = imp + (4 * u + (c >> 2)) * 260;
        row[bj] = 2.f * (pr[0] + pr[1] + pr[2]) + pr[3] + cin;
        row[bj + 1] = 2.f * (pr[4] + pr[5] + pr[6]) + pr[7] + pr[3];
      }
    }
    return;
  }
  float mx = v[0];
#pragma unroll
  for (int i = 1; i < 16; ++i) mx = fmaxf(mx, v[i]);
  if (interior) mx = colok ? mx : -1e30f;
  mx = xmax16(xmax32(mx));
  const float mnew = fmaxf(mrun, mx);
  const float alpha = __builtin_amdgcn_exp2f(mrun - mnew);
  mrun = mnew;
  float ls = 0.f;
  if (interior) {
    const float meff = colok ? mnew : 1e30f;
#pragma unroll
    for (int i = 0; i < 16; ++i) {
      v[i] = __builtin_amdgcn_exp2f(v[i] - meff);
      ls += v[i];
    }
  } else {
#pragma unroll
    for (int i = 0; i < 16; ++i) {
      v[i] = ok[i] ? __builtin_amdgcn_exp2f(v[i] - mnew) : 0.f;
      ls += v[i];
    }
  }
  lrun = lrun * alpha + ls;
  if (__builtin_amdgcn_ballot_w64(alpha != 1.f)) {
#pragma unroll
    for (int d = 0; d < 8; ++d) O[d] *= alpha;
  }
  __builtin_amdgcn_sched_barrier(0);
#pragma unroll
  for (int half = 0; half < 2; ++half) {
    const bf16x8 pb = pack8_mfma(v[8 * half], v[8 * half + 1], v[8 * half + 2], v[8 * half + 3], v[8 * half + 4], v[8 * half + 5],
                                 v[8 * half + 6], v[8 * half + 7]);
    bf16x8 va[8];
#pragma unroll
    for (int d = 0; d < 8; ++d) va[d] = *(const bf16x8*)(stage + 16384 + ((16 * d + c) * 8 + ((4 * half + g) ^ ((c >> 1) & 7))) * 16);
#pragma unroll
    for (int d = 0; d < 8; ++d) O[d] = MFMA(va[d], pb, O[d]);
    __builtin_amdgcn_sched_group_barrier(0x100, 8, 0);
    __builtin_amdgcn_sched_group_barrier(0x008, 8, 0);
    __builtin_amdgcn_sched_barrier(0);
  }
}

DI int next_set256(unsigned long long n0, unsigned long long n1, unsigned long long n2, unsigned long long n3, int from) {
  if (from >= 256) return 256;
  const int wd = from >> 6, sh = from & 63;
  unsigned long long b0 = (wd == 0) ? (n0 >> sh) << sh : 0ull;
  unsigned long long b1 = (wd <= 1) ? ((wd == 1) ? (n1 >> sh) << sh : n1) : 0ull;
  unsigned long long b2 = (wd <= 2) ? ((wd == 2) ? (n2 >> sh) << sh : n2) : 0ull;
  unsigned long long b3 = (wd == 3) ? (n3 >> sh) << sh : n3;
  if (b0) return __builtin_ctzll(b0);
  if (b1) return 64 + __builtin_ctzll(b1);
  if (b2) return 128 + __builtin_ctzll(b2);
  if (b3) return 192 + __builtin_ctzll(b3);
  return 256;
}

template <int MODE>
DI void nsa_block_loop(const u16* Kg, const u16* Vg, int jfirst, int jlast, const u32* selmask, char* stage,
                       const bf16x8 (&qf)[2][4], f32x4 (&O)[2][8], float (&mrun)[2], float (&lrun)[2], int tbase,
                       const float (&invl)[2], float* imp, int) {
  const int tid = my_tid(), l = tid & 63, w = tid >> 6, c = l & 15, g = l >> 4;
  const int krow = tid >> 2, kcq = tid & 3, vrow = tid >> 1, vcq = tid & 1;
  const int khs = (krow & 3) | (((krow >> 3) & 3) << 2);
  const int vhs = (vrow >> 1) & 7;
  constexpr bool HASV = (MODE != NSA_CMP2);
  constexpr bool MASKED = (MODE == NSA_SEL);
  uint4 kr0, kr1, kr2, kr3, vr0, vr1, vr2, vr3;
  float cin0 = 0.f, cin1 = 0.f;
  int j = jfirst;
  unsigned long long nz0 = 0, nz1 = 0, nz2 = 0, nz3 = 0;
  u32 mcur = 0u;
  if (MASKED) {
    nz0 = __builtin_amdgcn_ballot_w64(selmask[l] != 0u);
    nz1 = __builtin_amdgcn_ballot_w64(selmask[64 + l] != 0u);
    nz2 = __builtin_amdgcn_ballot_w64(selmask[128 + l] != 0u);
    nz3 = __builtin_amdgcn_ballot_w64(selmask[192 + l] != 0u);
    j = next_set256(nz0, nz1, nz2, nz3, jfirst);
    if (j <= jlast) mcur = selmask[j];
  }
#define NSA_LOADBLK(jj)                                                    \
  {                                                                        \
    const uint4* ks = (const uint4*)(Kg + (long)(jj) * 8192 + tid * 32);    \
    kr0 = ks[0]; kr1 = ks[1]; kr2 = ks[2]; kr3 = ks[3];                     \
    if (HASV) {                                                            \
      const uint4* vs = (const uint4*)(Vg + (long)(jj) * 8192 + tid * 32);  \
      vr0 = vs[0]; vr1 = vs[1]; vr2 = vs[2]; vr3 = vs[3];                   \
    }                                                                      \
  }
  if (j <= jlast) NSA_LOADBLK(j);
  while (j <= jlast) {
    *(uint4*)(stage + (krow * 16 + ((4 * kcq + 0) ^ khs)) * 16) = kr0;
    *(uint4*)(stage + (krow * 16 + ((4 * kcq + 1) ^ khs)) * 16) = kr1;
    *(uint4*)(stage + (krow * 16 + ((4 * kcq + 2) ^ khs)) * 16) = kr2;
    *(uint4*)(stage + (krow * 16 + ((4 * kcq + 3) ^ khs)) * 16) = kr3;
    if (HASV) {
      *(uint4*)(stage + 16384 + (vrow * 8 + ((4 * vcq + 0) ^ vhs)) * 16) = vr0;
      *(uint4*)(stage + 16384 + (vrow * 8 + ((4 * vcq + 1) ^ vhs)) * 16) = vr1;
      *(uint4*)(stage + 16384 + (vrow * 8 + ((4 * vcq + 2) ^ vhs)) * 16) = vr2;
      *(uint4*)(stage + 16384 + (vrow * 8 + ((4 * vcq + 3) ^ vhs)) * 16) = vr3;
    }
    __syncthreads();
    int jn = j + 1;
    u32 mnext = 0u;
    if (MASKED) {
      jn = next_set256(nz0, nz1, nz2, nz3, j + 1);
      mnext = selmask[min(jn, 255)];
    }
    NSA_LOADBLK(jn <= jlast ? jn : j);
    u32 m8 = 0xffu;
    if (MASKED) m8 = (__builtin_amdgcn_readfirstlane(mcur) >> (8 * w)) & 0xffu;
    nsa_block_compute<MODE, 0>(stage, m8, j, qf[0], O[0], mrun[0], lrun[0], tbase, invl[0], cin0, imp, l, w, c, g);
    nsa_block_compute<MODE, 1>(stage, m8, j, qf[1], O[1], mrun[1], lrun[1], tbase, invl[1], cin1, imp, l, w, c, g);
    __syncthreads();
    j = jn;
    mcur = mnext;
  }
#undef NSA_LOADBLK
  if (MODE == NSA_CMP2) {
    if (jlast >= jfirst && g == 0 && (c & 3) == 0) {
      imp[(c >> 2) * 260 + 16 * (jlast + 1)] = cin0;
      imp[(4 + (c >> 2)) * 260 + 16 * (jlast + 1)] = cin1;
    }
  }
}

#define NSA_RECOORD                                                                                      \
  const int tid_ = my_tid(), l_ = tid_ & 63, w_ = tid_ >> 6, c_ = l_ & 15, g_ = l_ >> 4;                   \
  const int head_ = grp * 4 + (c_ & 3);                                                                  \
  const int mrow_ = b * T + tbase + 8 * w_ + (c_ >> 2);                                                  \
  f32x4* scr_ = (f32x4*)(p.ws + OFF_KV) + (((long)blockIdx.x * 4 + w_) * 64 + l_) * 16;                  \
  (void)g_; (void)head_; (void)mrow_; (void)scr_;
DI void nsa_item(const Params& p, int item, char* smem) {
  const int tid = my_tid(), l = tid & 63, w = tid >> 6, c = l & 15, g = l >> 4;
  int bg, tile;
  if (gridDim.x == 512) {
    const int k = item >> 9, q = (item & 511) >> 3;
    const int base = q + 64 * (k >> 1);
    bg = item & 7;
    const int flip = (int)(blockIdx.x >> 8) & 1;
    tile = ((k & 1) ^ flip) ? base : 511 - base;
  } else {
    bg = item >> 9;
    const int s512 = item & 511;
    tile = (bg & 1) ? 511 - s512 : s512;
  }
  const int b = bg >> 2, grp = bg & 3;
  const int tbase = tile * 32;
  const int cur = tbase >> 6;
  const int head = grp * 4 + (c & 3);
  float* imp = (float*)(smem + NSA_IMP_OFF + w * NSA_IMP_WAVE);
  u32* selmask = (u32*)(smem + NSA_MASK_OFF);
  u16* Qn = (u16*)(p.ws + OFF_QN);
  const float* gates = (const float*)(p.ws + OFF_GATES);

  selmask[tid] = 0u;
  for (int i = l; i < 8 * 260; i += 64) imp[i] = 0.f;
  __syncthreads();

  bf16x8 qf[2][4];
  const int mrow0 = b * T + tbase + 8 * w + (c >> 2);
#pragma unroll
  for (int u = 0; u < 2; ++u) {
#pragma unroll
    for (int ds = 0; ds < 4; ++ds) qf[u][ds] = *(const bf16x8*)(Qn + (long)(mrow0 + 4 * u) * 2048 + head * 128 + 32 * ds + 8 * g);
  }
  f32x4 O[2][8];
  float mrun[2], lrun[2], invl[2];
#pragma unroll
  for (int u = 0; u < 2; ++u) {
    mrun[u] = -1e30f;
    lrun[u] = 0.f;
    invl[u] = 0.f;
#pragma unroll
    for (int d = 0; d < 8; ++d) O[u][d] = f32x4{0.f, 0.f, 0.f, 0.f};
  }
  const int ncvmax = max(0, (tbase + 31 - 15) >> 4);
  const int nbc = (ncvmax + 63) >> 6;
  const u16* Kc = (const u16*)(p.ws + OFF_KCMP) + (long)bg * 1024 * 128;
  const u16* Vc = (const u16*)(p.ws + OFF_VCMPT) + (long)bg * 128 * 1024;
  nsa_block_loop<NSA_CMP1>(Kc, Vc, 0, nbc - 1, selmask, smem, qf, O, mrun, lrun, tbase, invl, imp, tid);
  {
    NSA_RECOORD
#pragma unroll
    for (int u = 0; u < 2; ++u) {
      const float ltot = xsum16(xsum32(lrun[u]));
      invl[u] = ltot > 0.f ? 1.f / ltot : 0.f;
      const float gc = gates[(mrow_ + 4 * u) * 48 + head_ * 3 + 0] * invl[u];
#pragma unroll
      for (int d = 0; d < 8; ++d) {
        scr_[u * 8 + d] = O[u][d] * gc;
        O[u][d] = f32x4{0.f, 0.f, 0.f, 0.f};
      }
    }
  }
  nsa_block_loop<NSA_CMP2>(Kc, Vc, 0, nbc - 1, selmask, smem, qf, O, mrun, lrun, tbase, invl, imp, tid);
  wave_lds_fence();
  for (int tk = 0; tk < 8; ++tk) {
    const int tt = tbase + 8 * w + tk;
    u32 key[4];
#pragma unroll
    for (int e = 0; e < 4; ++e) {
      const int j = l + 64 * e;
      const float v = imp[tk * 260 + j];
      const bool forced = (j == 0) || (j == cur) || (j == cur - 1);
      const float sc = forced ? 1e30f : fmaxf(v, 0.f);
      key[e] = (j <= cur) ? ((__float_as_uint(sc) & ~0x1ffu) | ((u32)(255 - j) << 1) | 1u) : 0u;
    }
    u32 ans = 0u;
    for (int bit = 31; bit >= 0; --bit) {
      const u32 cand = ans | (1u << bit);
      int cnt = 0;
#pragma unroll
      for (int e = 0; e < 4; ++e) cnt += __builtin_popcountll(__builtin_amdgcn_ballot_w64(key[e] >= cand));
      if (cnt >= 16) ans = cand;
    }
#pragma unroll
    for (int e = 0; e < 4; ++e)
      if (key[e] != 0u && key[e] >= ans) atomicOr(&selmask[l + 64 * e], 1u << (8 * w + tk));
  }
  __syncthreads();

#pragma unroll
  for (int u = 0; u < 2; ++u) {
    mrun[u] = -1e30f;
    lrun[u] = 0.f;
  }
  nsa_block_loop<NSA_SEL>(kvpart(p, 2) + (long)bg * T * 128, kvpart(p, 3) + (long)bg * 256 * 128 * 64, 0, cur, selmask, smem, qf, O, mrun,
                          lrun, tbase, invl, imp, tid);
  {
    NSA_RECOORD
#pragma unroll
    for (int u = 0; u < 2; ++u) {
      const float ltot = xsum16(xsum32(lrun[u]));
      const float gs = gates[(mrow_ + 4 * u) * 48 + head_ * 3 + 1] / ltot;
#pragma unroll
      for (int d = 0; d < 8; ++d) {
        f32x4 a = scr_[u * 8 + d];
        a += O[u][d] * gs;
        scr_[u * 8 + d] = a;
        O[u][d] = f32x4{0.f, 0.f, 0.f, 0.f};
      }
      mrun[u] = -1e30f;
      lrun[u] = 0.f;
    }
  }
  nsa_block_loop<NSA_WIN>(kvpart(p, 4) + (long)bg * T * 128, kvpart(p, 5) + (long)bg * 256 * 128 * 64, max(0, tbase - 511) >> 6, cur,
                          selmask, smem, qf, O, mrun, lrun, tbase, invl, imp, tid);
  {
    NSA_RECOORD
#pragma unroll
    for (int u = 0; u < 2; ++u) {
      const float ltot = xsum16(xsum32(lrun[u]));
      const float gw = gates[(mrow_ + 4 * u) * 48 + head_ * 3 + 2] / ltot;
#pragma unroll
      for (int d = 0; d < 8; ++d) {
        f32x4 a = scr_[u * 8 + d];
        a += O[u][d] * gw;
        *(uint2*)(Qn + (long)(mrow_ + 4 * u) * 2048 + head_ * 128 + 16 * d + 4 * g_) = pack4(a[0], a[1], a[2], a[3]);
      }
    }
  }
}
#undef NSA_RECOORD

#define XB_TMO      128
#define XB_XCNT(j)  (256  + 64 * (j))
#define XB_XSUB(j)  (1280 + 64 * (j))
#define XB_XGEN(j)  (2304 + 64 * (j))
#define XB_TOP      3328
#define XB_TOPGEN   3392
#define XCD_BAR_WORDS 3456
#define XB_SPIN_CAP (1u << 18)
#define LAS __attribute__((address_space(3)))

__device__ __forceinline__ unsigned xb_ld(unsigned* p)              { return __hip_atomic_load(p, __ATOMIC_RELAXED, __HIP_MEMORY_SCOPE_AGENT); }
__device__ __forceinline__ unsigned xb_add(unsigned* p, unsigned v) { return __hip_atomic_fetch_add(p, v, __ATOMIC_RELAXED, __HIP_MEMORY_SCOPE_AGENT); }
__device__ __forceinline__ unsigned xb_xcc_id() { return (unsigned)__builtin_amdgcn_s_getreg((3 << 11) | 20) & 0xFu; }
#define XB_SPIN(cond, bar) do { unsigned _sp = 0; while (cond) { __builtin_amdgcn_s_sleep(1); \
    if ((++_sp & 255u) == 0u) { if (xb_ld(&(bar)[XB_TMO])) break; if (_sp > XB_SPIN_CAP) { atomicAdd(&(bar)[XB_TMO], 1u); break; } } } } while (0)

struct XcdBarrier {
    unsigned* bar; unsigned x;
    volatile LAS unsigned* st;
};

__device__ __forceinline__ XcdBarrier xcd_barrier_post(unsigned* bar, volatile LAS unsigned* st) {
    XcdBarrier b; b.bar = bar; b.x = xb_xcc_id(); b.st = st;
    if (threadIdx.x == 0) (void)xb_add(&bar[XB_XCNT(b.x)], 1u);
    return b;
}
__device__ __forceinline__ void xcd_barrier_complete(unsigned* bar, unsigned x, unsigned& nloc, unsigned& nx) {
    const unsigned G = gridDim.x * gridDim.y * gridDim.z;
    unsigned sum, cnt, mine, sp = 0u;
    for (;;) {
        sum = 0u; cnt = 0u; mine = 0u;
#pragma unroll
        for (unsigned j = 0; j < 16; ++j) { const unsigned c = xb_ld(&bar[XB_XCNT(j)]); sum += c; cnt += (c > 0u) ? 1u : 0u; mine = (j == x) ? c : mine; }
        if (sum == G) break;
        __builtin_amdgcn_s_sleep(1);
        if ((++sp & 255u) == 0u) { if (xb_ld(&bar[XB_TMO])) break; if (sp > XB_SPIN_CAP) { atomicAdd(&bar[XB_TMO], 1u); break; } }
    }
    nloc = mine > 0u ? mine : 1u; nx = cnt > 0u ? cnt : 1u;
}

__device__ __forceinline__ void xcd_barrier(const XcdBarrier& b) {
    asm volatile("s_waitcnt vmcnt(0)" ::: "memory");
    __syncthreads();
    if (threadIdx.x == 0) {
        unsigned* bar = b.bar;
        __builtin_amdgcn_s_waitcnt(0);
        unsigned nloc = b.st[0], nx = b.st[1];
        if (nloc == 0u) { xcd_barrier_complete(bar, b.x, nloc, nx); b.st[0] = nloc; b.st[1] = nx; }
        const unsigned old = xb_add(&bar[XB_XSUB(b.x)], 1u);
        const unsigned gen = old / nloc;
        if (old + 1u == (gen + 1u) * nloc) {
            __builtin_amdgcn_fence(__ATOMIC_RELEASE, "agent");
            asm volatile("s_waitcnt vmcnt(0)" ::: "memory");
            const unsigned og = xb_add(&bar[XB_TOP], 1u);
            const unsigned tg = og / nx;
            if (og + 1u == (tg + 1u) * nx) xb_add(&bar[XB_TOPGEN], 1u);
            else XB_SPIN(xb_ld(&bar[XB_TOPGEN]) == tg, bar);
            __builtin_amdgcn_fence(__ATOMIC_ACQUIRE, "agent");
            xb_add(&bar[XB_XGEN(b.x)], 1u);
            asm volatile("s_waitcnt vmcnt(0)" ::: "memory");
        } else {
            XB_SPIN(xb_ld(&bar[XB_XGEN(b.x)]) == gen, bar);
            __builtin_amdgcn_fence(__ATOMIC_ACQUIRE, "agent");
            asm volatile("s_waitcnt vmcnt(0)" ::: "memory");
        }
    }
    __syncthreads();
}


constexpr long OFF_XBAR = OFF_BIAS + 512 * 1024;

constexpr int NPHASE = 19;
DI void run_phase(const Params& p, int ph, char* smem) {
  const int bid = blockIdx.x, nb = gridDim.x;
#ifdef PH_ONLY
  if (ph != PH_ONLY) return;
  ph = PH_ONLY;
#endif
  switch (ph) {
    case 0: {
      for (int i = bid; i < CONV_TILES; i += nb) conv_tile(p, i, smem);
      {
        u32* z = (u32*)(wsW(p) + W_NSA + 2096l * 1024);
        for (int i = bid * 256 + my_tid(); i < 80 * 512; i += nb * 256) z[i] = 0u;
      }
      for (int i = bid; i < 64; i += nb) bias_item(p, i, smem);
      {
        float* z = (float*)(p.ws + OFF_SSQ1);
        for (int i = bid * 256 + my_tid(); i < 3 * 32768; i += nb * 256) z[i] = 0.f;
      }
      for (int i = bid; i < M / 4; i += nb) rownorm_item(p, p.x, i);
    } break;
    case 1: for (int i = bid; i < 128 * 32; i += nb) ret_qkv_tile(p, i, smem); break;
    case 2: for (int i = bid; i < 1024; i += nb) ret_p_tile(p, i, smem); break;
    case 3: for (int i = bid; i < 256; i += nb) ret_scan_item(p, i, smem); break;
    case 4: for (int i = bid; i < M / 4; i += nb) stats_item(p, i); break;
    case 5: for (int i = bid; i < 128 * 16; i += nb) ret_gate_tile(p, i, smem); break;
    case 6: for (int i = bid; i < 128 * 8; i += nb) ret_out_tile(p, i, smem); break;
    case 7: for (int i = bid; i < M / 4; i += nb) rownorm_item(p, p.out, i); break;
    case 8: for (int i = bid; i < 256 * 8; i += nb) ple_tile(p, 0, i, smem); break;
    case 9: for (int i = bid; i < M / 4; i += nb) rownorm_item(p, p.out, i); break;
    case 10: for (int i = bid; i < 128 * 24; i += nb) kv_tile(p, i, smem); break;
    case 11: {
      const int half = nb >> 1;
      if (bid < half) {
        for (int i = bid; i < 256; i += half) cmp1_tile(p, i, smem);
      } else {
        for (int i = bid - half; i < 128 * 17; i += nb - half) nsaq_tile(p, i, smem);
      }
    } break;
    case 12: for (int i = bid; i < 128; i += nb) cmp2_tile(p, i, smem); break;
    case 13: for (int i = bid; i < 8 * 512; i += nb) nsa_item(p, i, smem); break;
    case 14: for (int i = bid; i < 128 * 16; i += nb) nsa_gate_tile(p, i, smem); break;
    case 15: for (int i = bid; i < 128 * 8; i += nb) nsa_out_tile(p, i, smem); break;
    case 16: for (int i = bid; i < M / 4; i += nb) rownorm_item(p, p.out, i); break;
    case 17: for (int i = bid; i < 256 * 8; i += nb) ple_tile(p, 1, i, smem); break;
    default: for (int i = bid; i < M / 4; i += nb) finalnorm_item(p, i); break;
  }
}

#if !MEGA
__global__ void __launch_bounds__(256) k_phase(Params p, int ph) {
  __shared__ __attribute__((aligned(16))) char smem[SMEM_BYTES];
  run_phase(p, ph, smem);
}

#else
__global__ void __launch_bounds__(256, 2) k_mega(Params p) {
  __shared__ __attribute__((aligned(16))) char smem[SMEM_BYTES];
  cg::grid_group grid = cg::this_grid();
  __shared__ uint4 xb_words;
  if (threadIdx.x == 0) xb_words = make_uint4(0u, 0u, 0u, 0u);
  __syncthreads();
  XcdBarrier xb = xcd_barrier_post((unsigned*)(p.ws + OFF_XBAR), (volatile LAS unsigned*)&xb_words);
  if (p.ws == nullptr) grid.sync();
  run_phase(p, 0, smem);
  xcd_barrier(xb);
#define PH(n) run_phase(p, n, smem); xcd_barrier(xb);
  PH(1) PH(2) PH(3) PH(4) PH(5) PH(6) PH(8) PH(10) PH(11) PH(12) PH(13) PH(14) PH(15) PH(17)
#undef PH
  run_phase(p, 18, smem);
}
#endif

extern "C" void kernel_launch(void* const* d_in, const int* in_sizes, int n_in, void* d_out, int out_size, void* d_ws,
                              size_t ws_size, hipStream_t stream) {
  if (ws_size < (size_t)WS_NEED) {
    fprintf(stderr, "workspace too small: %zu\n", ws_size);
    return;
  }
  Params p{};
  const float** f = (const float**)&p;
  for (int i = 0; i < 21; ++i) f[i] = (const float*)d_in[i];
  p.out = (float*)d_out;
  p.ws = (char*)d_ws;
  static int grid_blocks = 0;
  if (!grid_blocks) {
    int dev = 0, cus = 0, per_cu = 0;
    (void)hipGetDevice(&dev);
    (void)hipDeviceGetAttribute(&cus, hipDeviceAttributeMultiprocessorCount, dev);
#if MEGA
    (void)hipOccupancyMaxActiveBlocksPerMultiprocessor(&per_cu, k_mega, 256, 0);
#else
    (void)hipOccupancyMaxActiveBlocksPerMultiprocessor(&per_cu, k_phase, 256, 0);
#endif
    if (per_cu < 1) per_cu = 1;
    grid_blocks = cus * per_cu;
    if (grid_blocks > 1024) grid_blocks = 1024;
  }
#if MEGA
  (void)hipMemsetAsync((char*)d_ws + OFF_XBAR, 0, XCD_BAR_WORDS * sizeof(unsigned), stream);
  void* args[] = {&p};
  hipError_t e = hipLaunchCooperativeKernel((void*)k_mega, dim3(grid_blocks), dim3(256), args, 0, stream);
  if (e != hipSuccess) fprintf(stderr, "cooperative launch failed: %s (grid %d)\n", hipGetErrorString(e), grid_blocks);
#else
  for (int ph = 0; ph < NPHASE; ++ph) k_phase<<<grid_blocks, 256, 0, stream>>>(p, ph);
#endif
}
```
